# Optimizing an MI355X kernel written in HIP

```python
import math
import jax, jax.numpy as jnp
from jax import lax
import numpy as np

D_MODEL = 2048
BATCH = 2
SEQ = 8192
DEPTH = 1
DEC_BATCH = 4
DEC_SEQ = 4096
PAST_LEN = 128

HEAD_DIM = 128
N_HEADS = D_MODEL // HEAD_DIM
HA = N_HEADS // 2
HN = N_HEADS - HA
DA = HEAD_DIM // 2
DV = HEAD_DIM
DN = HEAD_DIM
W_A = HA * DV
W_N = HN * DN
IN_COLS = 3 * W_A + 3 * W_N
D_FF = ((8 * D_MODEL // 3 + 127) // 128) * 128
CONV_W = 3
GRID_W = 64
NA_MAX_ROWS = 8
NA_COLS = 16
NUM_BUCKETS = 32
MAX_DISTANCE = 128
QBLK = 128
EPS = 1e-6

kernel_name = "hybrid_diffattn_natten_convffn_encoder"


def rms_norm(x, g):
    xf = x.astype(jnp.float32)
    y = xf * lax.rsqrt(jnp.mean(xf * xf, axis=-1, keepdims=True) + EPS)
    return (y * g.astype(jnp.float32)).astype(x.dtype)


def t5_bucket(rel):
    nb = NUM_BUCKETS // 2
    max_exact = nb // 2
    ret = jnp.where(rel > 0, nb, 0)
    n = jnp.abs(rel)
    nf = jnp.maximum(n, 1).astype(jnp.float32)
    large = max_exact + (jnp.log(nf / max_exact) / math.log(MAX_DISTANCE / max_exact)
                         * (nb - max_exact)).astype(jnp.int32)
    large = jnp.minimum(large, nb - 1)
    return ret + jnp.where(n < max_exact, n, large)


def diff_attention(q, k, v, lam, lam_init, rel_table, subln_g):
    B, L = q.shape[0], q.shape[1]
    nblk = L // QBLK
    scale = DA ** -0.5
    qb = q.reshape(B, nblk, QBLK, HA, 2, DA).transpose(1, 0, 2, 3, 4, 5)
    kpos = jnp.arange(L, dtype=jnp.int32)

    def block(args):
        qi, i = args
        qpos = i * QBLK + jnp.arange(QBLK, dtype=jnp.int32)
        bias = rel_table[t5_bucket(kpos[None, :] - qpos[:, None])]
        bias = bias.transpose(2, 0, 1).astype(jnp.float32)
        s = jnp.einsum('bqhcd,bkhcd->bhcqk', qi, k).astype(jnp.float32) * scale
        p = jax.nn.softmax(s + bias[None, :, None], axis=-1)
        a = p[:, :, 0] - lam * p[:, :, 1]
        return jnp.einsum('bhqk,bkhe->bqhe', a.astype(v.dtype), v)

    o = lax.map(block, (qb, jnp.arange(nblk, dtype=jnp.int32)))
    o = o.transpose(1, 0, 2, 3, 4).reshape(B, L, HA, DV)
    o = rms_norm(o, subln_g) * (1.0 - lam_init)
    return o.reshape(B, L, W_A)


def neighborhood_attention(q, k, v, rpb):
    B, L = q.shape[0], q.shape[1]
    rows = L // GRID_W
    kh = min(NA_MAX_ROWS, rows)
    scale = DN ** -0.5
    c = jnp.arange(GRID_W, dtype=jnp.int32)
    cs = jnp.clip(c - NA_COLS // 2, 0, GRID_W - NA_COLS)
    kcol = cs[:, None] + jnp.arange(NA_COLS, dtype=jnp.int32)
    dc = kcol - c[:, None] + (NA_COLS - 1)
    qr = q.reshape(B, rows, GRID_W, HN, DN).transpose(1, 0, 2, 3, 4)

    def row(args):
        qi, r = args
        rs = jnp.clip(r - kh // 2, 0, rows - kh)
        krow = rs + jnp.arange(kh, dtype=jnp.int32)
        idx = (krow[None, :, None] * GRID_W + kcol[:, None, :]).reshape(GRID_W, kh * NA_COLS)
        kg = k[:, idx]
        vg = v[:, idx]
        dr = krow - r + (NA_MAX_ROWS - 1)
        bias = rpb[:, dr[None, :, None], dc[:, None, :]]
        bias = bias.reshape(HN, GRID_W, kh * NA_COLS).astype(jnp.float32)
        s = jnp.einsum('bqhd,bqnhd->bhqn', qi, kg).astype(jnp.float32) * scale
        p = jax.nn.softmax(s + bias[None], axis=-1)
        return jnp.einsum('bhqn,bqnhd->bqhd', p.astype(v.dtype), vg)

    o = lax.map(row, (qr, jnp.arange(rows, dtype=jnp.int32)))
    return o.transpose(1, 0, 2, 3, 4).reshape(B, L, W_N)


def conv_glu_ffn(x, w_up, conv_w, conv_b, w_down):
    h = x @ w_up
    a, g = h[..., :D_FF], h[..., D_FF:]
    ap = jnp.pad(a, ((0, 0), (1, 1), (0, 0)))
    a = ap[:, :-2] * conv_w[0] + ap[:, 1:-1] * conv_w[1] + ap[:, 2:] * conv_w[2] + conv_b
    return (jax.nn.gelu(a) * g) @ w_down


def trunk(x, w_in, w_out, norm1_g, norm2_g, final_g, lambda_q1, lambda_k1, lambda_q2,
          lambda_k2, subln_g, rel_bias_table, na_rpb, w_up, conv_w, conv_b, w_down):
    B, L = x.shape[0], x.shape[1]
    for l in range(DEPTH):
        lam_init = 0.8 - 0.6 * math.exp(-0.3 * l)
        lam = (jnp.exp(jnp.sum(lambda_q1[l].astype(jnp.float32) * lambda_k1[l].astype(jnp.float32)))
               - jnp.exp(jnp.sum(lambda_q2[l].astype(jnp.float32) * lambda_k2[l].astype(jnp.float32)))
               + lam_init)
        h = rms_norm(x, norm1_g[l])
        proj = h @ w_in[l]
        qa = proj[..., 0:W_A].reshape(B, L, HA, 2, DA)
        ka = proj[..., W_A:2 * W_A].reshape(B, L, HA, 2, DA)
        va = proj[..., 2 * W_A:3 * W_A].reshape(B, L, HA, DV)
        o0 = 3 * W_A
        qn = proj[..., o0:o0 + W_N].reshape(B, L, HN, DN)
        kn = proj[..., o0 + W_N:o0 + 2 * W_N].reshape(B, L, HN, DN)
        vn = proj[..., o0 + 2 * W_N:o0 + 3 * W_N].reshape(B, L, HN, DN)
        oa = diff_attention(qa, ka, va, lam, lam_init, rel_bias_table, subln_g[l])
        on = neighborhood_attention(qn, kn, vn, na_rpb[l])
        x = x + jnp.concatenate([oa, on], axis=-1) @ w_out[l]
        x = x + conv_glu_ffn(rms_norm(x, norm2_g[l]), w_up[l], conv_w[l], conv_b[l], w_down[l])
    return rms_norm(x, final_g)


def setup_inputs(seed: int = 0) -> dict:
    key = jax.random.key(seed)
    ks = jax.random.split(key, 20)
    f32 = jnp.float32
    nrm = lambda k, s, sc: jax.random.normal(k, s, f32) * sc
    return {
        "x_prompt": nrm(ks[0], (BATCH, SEQ, D_MODEL), 1.0),
        "x_sample": nrm(ks[1], (DEC_BATCH, DEC_SEQ, D_MODEL), 1.0),
        "w_in": nrm(ks[2], (DEPTH, D_MODEL, IN_COLS), D_MODEL ** -0.5),
        "w_out": nrm(ks[3], (DEPTH, W_A + W_N, D_MODEL), (W_A + W_N) ** -0.5),
        "norm1_g": 1.0 + nrm(ks[4], (DEPTH, D_MODEL), 0.02),
        "norm2_g": 1.0 + nrm(ks[5], (DEPTH, D_MODEL), 0.02),
        "final_g": 1.0 + nrm(ks[6], (D_MODEL,), 0.02),
        "lambda_q1": nrm(ks[7], (DEPTH, DA), 0.1),
        "lambda_k1": nrm(ks[8], (DEPTH, DA), 0.1),
        "lambda_q2": nrm(ks[9], (DEPTH, DA), 0.1),
        "lambda_k2": nrm(ks[10], (DEPTH, DA), 0.1),
        "subln_g": 1.0 + nrm(ks[11], (DEPTH, DV), 0.02),
        "rel_bias_table": nrm(ks[12], (NUM_BUCKETS, HA), 0.1),
        "na_rpb": nrm(ks[13], (DEPTH, HN, 2 * NA_MAX_ROWS - 1, 2 * NA_COLS - 1), 0.1),
        "w_up": nrm(ks[14], (DEPTH, D_MODEL, 2 * D_FF), D_MODEL ** -0.5),
        "conv_w": nrm(ks[15], (DEPTH, CONV_W, D_FF), CONV_W ** -0.5),
        "conv_b": nrm(ks[16], (DEPTH, D_FF), 0.01),
        "w_down": nrm(ks[17], (DEPTH, D_FF, D_MODEL), D_FF ** -0.5),
    }


def reference(x_prompt, x_sample, w_in, w_out, norm1_g, norm2_g, final_g, lambda_q1, lambda_k1,
              lambda_q2, lambda_k2, subln_g, rel_bias_table, na_rpb, w_up, conv_w, conv_b, w_down):
    y_prompt = trunk(x_prompt, w_in, w_out, norm1_g, norm2_g, final_g, lambda_q1, lambda_k1,
                     lambda_q2, lambda_k2, subln_g, rel_bias_table, na_rpb, w_up, conv_w, conv_b, w_down)
    y_sample = trunk(x_sample, w_in, w_out, norm1_g, norm2_g, final_g, lambda_q1, lambda_k1,
                     lambda_q2, lambda_k2, subln_g, rel_bias_table, na_rpb, w_up, conv_w, conv_b, w_down)
    return (y_prompt, y_sample)
```

```cpp
#include <hip/hip_runtime.h>
#include <hip/hip_cooperative_groups.h>
#include <cstdio>
#include <cstdint>
namespace pg8 {
#define PG8_LAS __attribute__((address_space(3)))
typedef unsigned short bf16_t;
typedef short bf16x8 __attribute__((ext_vector_type(8)));
typedef float f32x4 __attribute__((ext_vector_type(4)));
typedef unsigned u32x4 __attribute__((ext_vector_type(4)));
constexpr int BM = 256, BK = 64, HALF = 128, HTB = HALF * BK * 2  , STAGE_BYTES = 8 * HTB, NXCD = 8, WGM = 8;

__host__ __device__ __forceinline__ int lds_byte(int r, int c) { const int st = (r >> 4) * 2 + (c >> 5), rr = r & 15, cc = c & 31, ob = rr * 64 + cc * 2; return st * 1024 + (ob ^ (((ob >> 9) & 1) << 5)); }
__host__ __device__ __forceinline__ void stage_rc(int b, int& R, int& C) { const int st = b / 1024, sb = b % 1024, swz = sb ^ (((sb >> 9) & 1) << 5); R = (st >> 1) * 16 + swz / 64; C = (st & 1) * 32 + (swz % 64) / 2; }
__host__ __device__ __forceinline__ int perm32(int rho) { const int n = rho >> 4, i = rho & 15; return 8 * (i >> 2) + 4 * n + (i & 3); }

struct Unit { int pm, pn; };
struct Gemm { const bf16_t* A; const bf16_t* Bt; int M, N, K; };

struct StaticOrder {
    int nM, nN, nwg, G, c;
    __host__ __device__ void init(int M, int N, int G_, int c_) { nM = M / BM; nN = N / BM; nwg = nM * nN; G = G_; c = c_; }
    __host__ __device__ bool next(int i, Unit& u) const {
        const long L = (long)i * G + c; if (L >= nwg) return false;
        int wgid = (int)L; { const int q = nwg / NXCD, r = nwg % NXCD, xcd = wgid % NXCD, off = wgid / NXCD; wgid = (xcd < r ? xcd * (q + 1) : r * (q + 1) + (xcd - r) * q) + off; }
        const int nig = WGM * nN, gid = wgid / nig, fm = gid * WGM, gsz = (nM - fm) < WGM ? (nM - fm) : WGM;
        u.pm = fm + ((wgid % nig) % gsz); u.pn = (wgid % nig) / gsz; return true;
    }
    __device__ __forceinline__ void a_ready(const Unit&) const {}
    __device__ __forceinline__ void done(const Unit&) const {}
};

__device__ __forceinline__ unsigned cvt_pk_bf16(float lo, float hi) { unsigned r; asm volatile("v_cvt_pk_bf16_f32 %0, %1, %2" : "=v"(r) : "v"(lo), "v"(hi)); return r; }
typedef float f32x2 __attribute__((ext_vector_type(2)));
__device__ __forceinline__ f32x2 gelu_pk(f32x2 v) {
    const f32x2 av = __builtin_elementwise_abs(v), d = av * 0.2316418882f + 1.0f;
    f32x2 t; t.x = __builtin_amdgcn_rcpf(d.x); t.y = __builtin_amdgcn_rcpf(d.y);
    f32x2 q = t * 0.5307027145f + (-0.7265760135f); q = q * t + 0.7107068705f; q = q * t + (-0.142248368f); q = q * t + 0.127414796f; q = q * t;
    const f32x2 s = (v * v) * (-0.72134752044f);
    f32x2 e; e.x = __builtin_amdgcn_exp2f(s.x); e.y = __builtin_amdgcn_exp2f(s.y);
    const f32x2 m = v * (q * e), r = v - m;
    f32x2 o; o.x = v.x < 0.f ? m.x : r.x; o.y = v.y < 0.f ? m.y : r.y; return o;
}

template <int ACT  > struct EpiBf16 {
    static constexpr bool PERM = true, AFTER_DRAIN = false; static_assert(ACT == 0 || ACT == 1, "EpiBf16: ACT is 0 (none) or 1 (gelu_pk)");
    bf16_t* O; int ldc; const float* bias; int split_cols; size_t split_stride; float scale0, scale1;
    __device__ __forceinline__ void operator()(const f32x4 (&acc)[2][2][4][2], const Unit& u, int wr, int wc, int fr, int fq) const {
        const int row0 = u.pm * BM + wr * 64 + fr; int colt = u.pn * BM; bf16_t* base = O;
        float sc = 1.f; if (split_cols) { const int t = colt / split_cols; base += (size_t)t * split_stride; colt -= t * split_cols; if (t == 0) sc = colt < 1024 ? scale0 : scale1; }
        const int col0 = colt + wc * 32 + 8 * fq, bcol0 = u.pn * BM + wc * 32 + 8 * fq;
        f32x4 bv[2][2];
#pragma unroll
        for (int bj = 0; bj < 2; ++bj)
#pragma unroll
            for (int n = 0; n < 2; ++n) bv[bj][n] = bias ? *(const f32x4*)(bias + bcol0 + bj * HALF + 4 * n) : (f32x4){0.f, 0.f, 0.f, 0.f};
#pragma unroll
        for (int ai = 0; ai < 2; ++ai)
#pragma unroll
            for (int m = 0; m < 4; ++m) { bf16_t* rowp = base + (size_t)(row0 + ai * HALF + m * 16) * ldc + col0;
#pragma unroll
                for (int bj = 0; bj < 2; ++bj) { f32x4 v0 = acc[ai][bj][m][0] + bv[bj][0], v1 = acc[ai][bj][m][1] + bv[bj][1];
                    if (ACT == 1) { f32x2 a = gelu_pk((f32x2){v0[0], v0[1]}), b = gelu_pk((f32x2){v0[2], v0[3]}), c = gelu_pk((f32x2){v1[0], v1[1]}), d = gelu_pk((f32x2){v1[2], v1[3]});
                        v0 = (f32x4){a.x, a.y, b.x, b.y}; v1 = (f32x4){c.x, c.y, d.x, d.y}; }
                    v0 = v0 * sc; v1 = v1 * sc; u32x4 w; w.x = cvt_pk_bf16(v0[0], v0[1]); w.y = cvt_pk_bf16(v0[2], v0[3]); w.z = cvt_pk_bf16(v1[0], v1[1]); w.w = cvt_pk_bf16(v1[2], v1[3]);
                    *(u32x4*)(rowp + bj * HALF) = w; } }
    }
};
typedef unsigned u32x2 __attribute__((ext_vector_type(2)));
constexpr int DM = 2048, DFF = 5504;
__device__ __forceinline__ float gelu_tanh(float x) {
    const float k2 = -2.0f * 0.7978845608028654f * 1.4426950408889634f;
    const float t = x * (1.0f + 0.044715f * x * x);
    const float e = __builtin_amdgcn_exp2f(k2 * t);
    return x * __builtin_amdgcn_rcpf(1.0f + e);
}
struct EpiOut {
    static constexpr bool PERM = true, AFTER_DRAIN = false;
    const float* xp; const float* xs; float* out; bf16_t* xn2; float* ss2;
    __device__ __forceinline__ void operator()(const f32x4 (&acc)[2][2][4][2], const Unit& u, int wr, int wc, int fr, int fq) const {
        const float* xin = (u.pm < 64) ? xp + (size_t)u.pm * (BM * DM) : xs + (size_t)(u.pm - 64) * (BM * DM);
        const int col0 = u.pn * BM + wc * 32 + 8 * fq;
#pragma unroll
        for (int ai = 0; ai < 2; ++ai)
#pragma unroll
            for (int m = 0; m < 4; ++m) { const int rl = ai * HALF + wr * 64 + m * 16 + fr; const size_t R = (size_t)u.pm * BM + rl; float q = 0.f;
#pragma unroll
                for (int bj = 0; bj < 2; ++bj) { const int cc = col0 + bj * HALF;
                    const f32x4 v0 = *(const f32x4*)(xin + (size_t)rl * DM + cc) + acc[ai][bj][m][0], v1 = *(const f32x4*)(xin + (size_t)rl * DM + cc + 4) + acc[ai][bj][m][1];
                    q += ((v0[0] * v0[0] + v0[1] * v0[1]) + (v0[2] * v0[2] + v0[3] * v0[3])) + ((v1[0] * v1[0] + v1[1] * v1[1]) + (v1[2] * v1[2] + v1[3] * v1[3]));
                    u32x4 w; w.x = cvt_pk_bf16(v0[0], v0[1]); w.y = cvt_pk_bf16(v0[2], v0[3]); w.z = cvt_pk_bf16(v1[0], v1[1]); w.w = cvt_pk_bf16(v1[2], v1[3]); *(u32x4*)(xn2 + R * DM + cc) = w; }
                q += __shfl_xor(q, 16); q += __shfl_xor(q, 32);
                if (fq == 0) atomicAdd(ss2 + R, q);
                asm volatile("" ::: "memory"); }
    }
};
struct EpiDown {
    static constexpr bool PERM = true, AFTER_DRAIN = false;
    float* out; float* ss3; bf16_t* res;
    __device__ __forceinline__ void operator()(const f32x4 (&acc)[2][2][4][2], const Unit& u, int wr, int wc, int fr, int fq) const {
        const int col0 = u.pn * BM + wc * 32 + 8 * fq;
#pragma unroll
        for (int ai = 0; ai < 2; ++ai)
#pragma unroll
            for (int m = 0; m < 4; ++m) { const int rl = ai * HALF + wr * 64 + m * 16 + fr; const size_t R = (size_t)u.pm * BM + rl; float q = 0.f;
#pragma unroll
                for (int bj = 0; bj < 2; ++bj) { bf16_t* p = res + R * DM + col0 + bj * HALF;
                    const u32x4 rw = *(const u32x4*)p;
                    const f32x4 r0 = {__uint_as_float(rw.x << 16), __uint_as_float(rw.x & 0xffff0000u), __uint_as_float(rw.y << 16), __uint_as_float(rw.y & 0xffff0000u)};
                    const f32x4 r1 = {__uint_as_float(rw.z << 16), __uint_as_float(rw.z & 0xffff0000u), __uint_as_float(rw.w << 16), __uint_as_float(rw.w & 0xffff0000u)};
                    const f32x4 v0 = r0 + acc[ai][bj][m][0], v1 = r1 + acc[ai][bj][m][1];
                    u32x4 w; w.x = cvt_pk_bf16(v0[0], v0[1]); w.y = cvt_pk_bf16(v0[2], v0[3]); w.z = cvt_pk_bf16(v1[0], v1[1]); w.w = cvt_pk_bf16(v1[2], v1[3]); *(u32x4*)p = w;
                    q += ((v0[0] * v0[0] + v0[1] * v0[1]) + (v0[2] * v0[2] + v0[3] * v0[3])) + ((v1[0] * v1[0] + v1[1] * v1[1]) + (v1[2] * v1[2] + v1[3] * v1[3])); }
                q += __shfl_xor(q, 16); q += __shfl_xor(q, 32);
                if (fq == 0) ss3[R * 32 + u.pn * 4 + wc] = q;
                asm volatile("" ::: "memory"); }
    }
};
struct EpiUp {
    static constexpr bool PERM = true, AFTER_DRAIN = false;
    bf16_t* U; const float* ss2; const float* cw; const float* cb; float* EP; float* EA; float* EG;
    __device__ __forceinline__ void operator()(const f32x4 (&acc)[2][2][4][2], const Unit& u, int wr, int wc, int fr, int fq) const {
        const int j0 = u.pn * 128 + wc * 32 + 8 * fq;
#pragma unroll
        for (int ai = 0; ai < 2; ++ai) {
            const int rb = u.pm * BM + ai * HALF + wr * 64;
            float s[4];
#pragma unroll
            for (int m = 0; m < 4; ++m) s[m] = __builtin_amdgcn_rsqf(ss2[rb + m * 16 + fr] * (1.0f / 2048.0f) + 1e-6f);
            const bool edge = (fr == 0 || fr == 15); u32x2 wl[4];
            const size_t eo = (size_t)(2 * (rb >> 6) + (fr == 15 ? 1 : 0)) * DFF + j0;
#pragma unroll
            for (int n = 0; n < 2; ++n) {
                const f32x4 w0 = *(const f32x4*)(cw + j0 + 4 * n), w1 = *(const f32x4*)(cw + DFF + j0 + 4 * n), w2 = *(const f32x4*)(cw + 2 * DFF + j0 + 4 * n), bb = *(const f32x4*)(cb + j0 + 4 * n);
                f32x4 ec, ea, eg; float uo[4][4];
#pragma unroll
                for (int e = 0; e < 4; ++e) {
                    float a[4], g[4], rp[4], rn[4], cv[4];
#pragma unroll
                    for (int m = 0; m < 4; ++m) { a[m] = acc[ai][0][m][n][e] * s[m]; g[m] = acc[ai][1][m][n][e] * s[m]; }
#pragma unroll
                    for (int m = 0; m < 4; ++m) {
                        rp[m] = __builtin_bit_cast(float, __builtin_amdgcn_update_dpp(0, __builtin_bit_cast(int, a[m]), 0x121, 0xF, 0xF, false));
                        rn[m] = __builtin_bit_cast(float, __builtin_amdgcn_update_dpp(0, __builtin_bit_cast(int, a[m]), 0x12F, 0xF, 0xF, false)); }
#pragma unroll
                    for (int m = 0; m < 4; ++m) {
                        const float pr = (fr > 0) ? rp[m] : (m > 0 ? rp[m > 0 ? m - 1 : 0] : 0.f);
                        const float nx = (fr < 15) ? rn[m] : (m < 3 ? rn[m < 3 ? m + 1 : 3] : 0.f);
                        cv[m] = w0[e] * pr + w1[e] * a[m] + w2[e] * nx + bb[e];
                        uo[m][e] = gelu_tanh(cv[m]) * g[m];
                    }
                    ec[e] = (fr == 0) ? cv[0] : cv[3]; ea[e] = (fr == 0) ? a[0] : a[3]; eg[e] = (fr == 0) ? g[0] : g[3];
                }
                if (edge) { *(f32x4*)(EP + eo + 4 * n) = ec; *(f32x4*)(EA + eo + 4 * n) = ea; *(f32x4*)(EG + eo + 4 * n) = eg; }
#pragma unroll
                for (int m = 0; m < 4; ++m) { u32x2 w; w.x = cvt_pk_bf16(uo[m][0], uo[m][1]); w.y = cvt_pk_bf16(uo[m][2], uo[m][3]);
                    if (n == 0) wl[m] = w; else { u32x4 ww; ww.x = wl[m].x; ww.y = wl[m].y; ww.z = w.x; ww.w = w.y; *(u32x4*)(U + (size_t)(rb + m * 16 + fr) * DFF + j0) = ww; } }
                asm volatile("" ::: "memory");
            }
            asm volatile("" ::: "memory");
        }
    }
};
template <class Epi, class Sched, bool ALIGN_EPI = false, bool SP2 = false>
__device__ __forceinline__ void gemm_phase(PG8_LAS unsigned char* lds, const Gemm g, const Sched& S, const Epi& E) {
    int tid_ = threadIdx.x; asm volatile("" : "+v"(tid_));
    const int tid = tid_, wid = __builtin_amdgcn_readfirstlane(tid >> 6), lane = tid & 63, wr = wid >> 2, wc = wid & 3, fr = lane & 15, fq = lane >> 4;
    const int K = g.K, nt = K / BK;
    unsigned voffA[2], voffB[2];
#pragma unroll
    for (int i = 0; i < 2; ++i) { int R, C; stage_rc(tid * 16 + i * 8192, R, C); const int Rb = Epi::PERM ? ((R & ~31) + perm32(R & 31)) : R;
        voffA[i] = (unsigned)(R * K + C) * 2u; voffB[i] = (unsigned)(Rb * K + C) * 2u; }
    const size_t kstep = (size_t)(BK * 2);
    const size_t hstep = (size_t)HALF * K * 2;
    const size_t tstep = 2 * hstep;
    const unsigned ldsw = (unsigned)wid * 1024u;
    const int aoff = lds_byte(wr * 64 + fr, fq * 8), boff = lds_byte(wc * 32 + fr, fq * 8);
#define PG8_SA(b, h) (((b) * 2 + (h)) * HTB)
#define PG8_SB(b, h) ((4 + (b) * 2 + (h)) * HTB)
#define PG8_STAGE(bufoff, gbase, voff) do { _Pragma("unroll") for (int _i = 0; _i < 2; ++_i) \
        __builtin_amdgcn_global_load_lds((const unsigned*)((const char*)(gbase) + (voff)[_i]), (PG8_LAS unsigned*)(lds + (bufoff) + ldsw + _i * 8192), 16, 0, 0); } while (0)
#define PG8_LDA(dst, b, h) do { _Pragma("unroll") for (int m = 0; m < 4; ++m) _Pragma("unroll") for (int k = 0; k < 2; ++k) dst[m][k] = *(const PG8_LAS bf16x8*)(lds + PG8_SA(b, h) + aoff + m * 2048 + k * 1024); } while (0)
#define PG8_LDB(dst, b, h) do { _Pragma("unroll") for (int n = 0; n < 2; ++n) _Pragma("unroll") for (int k = 0; k < 2; ++k) dst[n][k] = *(const PG8_LAS bf16x8*)(lds + PG8_SB(b, h) + boff + n * 2048 + k * 1024); } while (0)
#define PG8_MMA(ai, bj, At, Bt) do { __builtin_amdgcn_s_setprio(1); _Pragma("unroll") for (int m = 0; m < 4; ++m) _Pragma("unroll") for (int n = 0; n < 2; ++n) _Pragma("unroll") for (int k = 0; k < 2; ++k) \
        acc[ai][bj][m][n] = __builtin_amdgcn_mfma_f32_16x16x32_bf16(Bt[n][k], At[m][k], acc[ai][bj][m][n], 0, 0, 0); __builtin_amdgcn_s_setprio(0); } while (0)
#define PG8_WAIT_V(n) asm volatile("s_waitcnt vmcnt(" #n ")" ::: "memory")
#define PG8_WAIT_L(n) asm volatile("s_waitcnt lgkmcnt(" #n ")" ::: "memory")
#define PG8_BAR __builtin_amdgcn_s_barrier()
#define PG8_SCHED __builtin_amdgcn_sched_barrier(0)
    Unit cur, nxt; int ui = 0;
    if (!S.next(0, cur)) return;
    f32x4 acc[2][2][4][2];
#pragma unroll
    for (int a = 0; a < 2; ++a)
#pragma unroll
        for (int b = 0; b < 2; ++b)
#pragma unroll
            for (int m = 0; m < 4; ++m)
#pragma unroll
                for (int n = 0; n < 2; ++n) acc[a][b][m][n] = (f32x4){0.f, 0.f, 0.f, 0.f};
    bf16x8 At[4][2], B0[2][2], B1[2][2];
    const char* cA = (const char*)g.A + (size_t)cur.pm * tstep; const char* cB = (const char*)g.Bt + (size_t)cur.pn * tstep;
    S.a_ready(cur);
    if constexpr (SP2) {
        PG8_STAGE(PG8_SB(0, 0), cB, voffB); PG8_STAGE(PG8_SB(0, 1), cB + hstep, voffB); PG8_STAGE(PG8_SA(0, 0), cA, voffA); PG8_STAGE(PG8_SA(0, 1), cA + hstep, voffA);
        if (wr == 1) PG8_BAR;
        PG8_WAIT_V(2); PG8_BAR;
        PG8_STAGE(PG8_SB(1, 0), cB + kstep, voffB); PG8_STAGE(PG8_SA(1, 0), cA + kstep, voffA); PG8_STAGE(PG8_SB(1, 1), cB + hstep + kstep, voffB);
        PG8_WAIT_V(6); PG8_BAR;
    } else {
        PG8_STAGE(PG8_SB(0, 0), cB, voffB); PG8_STAGE(PG8_SA(0, 0), cA, voffA); PG8_STAGE(PG8_SB(0, 1), cB + hstep, voffB); PG8_STAGE(PG8_SA(0, 1), cA + hstep, voffA);
        if (wr == 1) PG8_BAR;
        PG8_WAIT_V(4); PG8_BAR;
        PG8_STAGE(PG8_SB(1, 0), cB + kstep, voffB); PG8_STAGE(PG8_SA(1, 0), cA + kstep, voffA); PG8_STAGE(PG8_SB(1, 1), cB + hstep + kstep, voffB);
        PG8_WAIT_V(6); PG8_BAR;
    }
    for (;;) {
        const bool has_next = S.next(ui + 1, nxt);
        const char* nA = has_next ? (const char*)g.A + (size_t)nxt.pm * tstep : cA; const char* nB = has_next ? (const char*)g.Bt + (size_t)nxt.pn * tstep : cB;
        for (int t = 0; t < nt; t += 2) {
            const bool last = (t == nt - 2);
            const char* a1 = cA + (size_t)(t + 1) * kstep;
            const char* a2 = last ? nA : cA + (size_t)(t + 2) * kstep; const char* b2 = last ? nB : cB + (size_t)(t + 2) * kstep;
            const char* a3 = a2 + kstep; const char* b3 = b2 + kstep;
            if (last && has_next) S.a_ready(nxt);
            if constexpr (SP2) {
            PG8_LDB(B0, 0, 0); PG8_LDB(B1, 0, 1); PG8_SCHED; PG8_LDA(At, 0, 0); PG8_STAGE(PG8_SA(1, 1), a1 + hstep, voffA);
            PG8_WAIT_V(8); PG8_WAIT_L(0); PG8_BAR; PG8_MMA(0, 0, At, B0); PG8_MMA(0, 1, At, B1); PG8_BAR; PG8_SCHED;
            PG8_LDA(At, 0, 1); PG8_STAGE(PG8_SB(0, 0), b2, voffB); PG8_STAGE(PG8_SB(0, 1), b2 + hstep, voffB); PG8_STAGE(PG8_SA(0, 0), a2, voffA);
            PG8_WAIT_V(8); PG8_WAIT_L(0); PG8_BAR; PG8_MMA(1, 0, At, B0); PG8_MMA(1, 1, At, B1); PG8_BAR; PG8_SCHED;
            PG8_LDB(B0, 1, 0); PG8_LDB(B1, 1, 1); PG8_SCHED; PG8_LDA(At, 1, 0); PG8_STAGE(PG8_SA(0, 1), a2 + hstep, voffA);
            PG8_WAIT_V(8); PG8_WAIT_L(0); PG8_BAR; PG8_MMA(0, 0, At, B0); PG8_MMA(0, 1, At, B1); PG8_BAR; PG8_SCHED;
            PG8_LDA(At, 1, 1); PG8_STAGE(PG8_SB(1, 0), b3, voffB); PG8_STAGE(PG8_SB(1, 1), b3 + hstep, voffB); PG8_STAGE(PG8_SA(1, 0), a3, voffA);
            PG8_WAIT_V(8); PG8_WAIT_L(0); PG8_BAR; PG8_MMA(1, 0, At, B0); PG8_MMA(1, 1, At, B1); PG8_BAR; PG8_SCHED;
            } else {
            PG8_LDB(B0, 0, 0); PG8_SCHED; PG8_LDA(At, 0, 0); PG8_STAGE(PG8_SA(1, 1), a1 + hstep, voffA);
            PG8_WAIT_L(8); PG8_BAR; PG8_WAIT_L(0); PG8_MMA(0, 0, At, B0); PG8_BAR; PG8_SCHED;
            PG8_LDB(B1, 0, 1); PG8_STAGE(PG8_SB(0, 0), b2, voffB);
            PG8_BAR; PG8_WAIT_L(0); PG8_MMA(0, 1, At, B1); PG8_BAR;
            PG8_LDA(At, 0, 1); PG8_STAGE(PG8_SA(0, 0), a2, voffA);
            PG8_BAR; PG8_WAIT_L(0); PG8_MMA(1, 0, At, B0); PG8_BAR; PG8_SCHED;
            PG8_STAGE(PG8_SB(0, 1), b2 + hstep, voffB);
            PG8_WAIT_V(6); PG8_BAR; PG8_MMA(1, 1, At, B1); PG8_BAR;
            PG8_LDB(B0, 1, 0); PG8_SCHED; PG8_LDA(At, 1, 0); PG8_STAGE(PG8_SA(0, 1), a2 + hstep, voffA);
            PG8_WAIT_L(8); PG8_BAR; PG8_WAIT_L(0); PG8_MMA(0, 0, At, B0); PG8_BAR; PG8_SCHED;
            PG8_LDB(B1, 1, 1); PG8_STAGE(PG8_SB(1, 0), b3, voffB);
            PG8_BAR; PG8_WAIT_L(0); PG8_MMA(0, 1, At, B1); PG8_BAR;
            PG8_LDA(At, 1, 1); PG8_STAGE(PG8_SA(1, 0), a3, voffA);
            PG8_BAR; PG8_WAIT_L(0); PG8_MMA(1, 0, At, B0); PG8_BAR; PG8_SCHED;
            PG8_STAGE(PG8_SB(1, 1), b3 + hstep, voffB);
            PG8_WAIT_V(6); PG8_BAR; PG8_MMA(1, 1, At, B1); PG8_BAR;
            }
        }
        if constexpr (ALIGN_EPI) { if (wr == 0) PG8_BAR; }
        if constexpr (!Epi::AFTER_DRAIN) { E(acc, cur, wr, wc, fr, fq); S.done(cur); }
        if (!has_next) break;
#pragma unroll
        for (int a = 0; a < 2; ++a)
#pragma unroll
            for (int b = 0; b < 2; ++b)
#pragma unroll
                for (int m = 0; m < 4; ++m)
#pragma unroll
                    for (int n = 0; n < 2; ++n) acc[a][b][m][n] = (f32x4){0.f, 0.f, 0.f, 0.f};
        cur = nxt; cA = nA; cB = nB; ++ui;
        if constexpr (ALIGN_EPI) { if (wr == 1) PG8_BAR; }
    }
    PG8_WAIT_V(0);
    if constexpr (!ALIGN_EPI) { if (wr == 0) PG8_BAR; }
    PG8_BAR;
    if constexpr (Epi::AFTER_DRAIN) { E.fused(acc, cur, wr, wc, fr, fq, lds, wid, lane); S.done(cur); }
#undef PG8_SA
#undef PG8_SB
#undef PG8_STAGE
#undef PG8_LDA
#undef PG8_LDB
#undef PG8_MMA
#undef PG8_WAIT_V
#undef PG8_WAIT_L
#undef PG8_BAR
#undef PG8_SCHED
}
}

#ifndef PG8_SP2
#define PG8_SP2 true
#endif
#ifndef PG8_ALIGN
#define PG8_ALIGN true
#endif
namespace att {
using bf16x8 = __attribute__((ext_vector_type(8))) short;
using s16x4  = __attribute__((ext_vector_type(4))) short;
using f32x16 = __attribute__((ext_vector_type(16))) float;
using u32x4  = __attribute__((ext_vector_type(4))) unsigned;
typedef unsigned short bf16r;
constexpr int LD = 2048, KVBLK = 64;
constexpr int SHM_V = 16384, SHM_K = 16384;
constexpr int SLOT = 32768, SLOT_K = 16384, OFF_WS = 3 * SLOT, OFF_TB = OFF_WS + 2048, OFF_STG_HI = OFF_TB + 8192, ATT_LDS = OFF_STG_HI + 32768;
__device__ __forceinline__ int stg_off(int w) { return w < 4 ? 2 * SLOT + w * 8192 : OFF_STG_HI + (w - 4) * 8192; }
constexpr float LOG2E = 1.4426950408889634f;
constexpr float THRL = 8.0f * 1.4426950408889634f;
#define KSWZ(row, colB) ((row) * 256 + ((colB) ^ (((row) & 7) << 4)))
#define SBAR() __builtin_amdgcn_sched_barrier(0)
__device__ __forceinline__ int crow(int r, int hi) { return (r & 3) + 8 * (r >> 2) + 4 * hi; }
__device__ __forceinline__ unsigned cvtpk(float lo, float hi) { unsigned r; asm volatile("v_cvt_pk_bf16_f32 %0, %1, %2" : "=v"(r) : "v"(lo), "v"(hi)); return r; }
__device__ __forceinline__ bf16x8 ld8(const bf16r* p) { return *reinterpret_cast<const bf16x8*>(p); }

__device__ __forceinline__ float rowmax32(const f32x16& p0, const f32x16& p1) {
  float pmax = p0[0];
#pragma unroll
  for (int r = 1; r < 16; ++r) pmax = fmaxf(pmax, p0[r]);
#pragma unroll
  for (int r = 0; r < 16; ++r) pmax = fmaxf(pmax, p1[r]);
  auto rr = __builtin_amdgcn_permlane32_swap(__float_as_uint(pmax), __float_as_uint(pmax), false, false);
  return fmaxf(__uint_as_float(rr[0]), __uint_as_float(rr[1]));
}
__device__ __forceinline__ void decide(float pmax, float& m_reg, float& mn, float& alpha) {
  const bool keep = __all(pmax - m_reg <= THRL);
  mn = keep ? m_reg : fmaxf(m_reg, pmax); alpha = keep ? 1.f : __builtin_amdgcn_exp2f(m_reg - mn); m_reg = mn;
}
__device__ __forceinline__ void scoreConst(f32x16& p0, f32x16& p1, float& m_reg, float& alpha) {
  const float pmax = rowmax32(p0, p1);
  alpha = 1.f;
  if (__builtin_expect(!__all(pmax <= THRL), 0)) { const float d = fmaxf(pmax, 0.f); m_reg += d; alpha = __builtin_amdgcn_exp2f(-d);
#pragma unroll
    for (int r = 0; r < 16; ++r) { p0[r] -= d; p1[r] -= d; } }
#pragma unroll
  for (int r = 0; r < 16; ++r) p0[r] = __builtin_amdgcn_exp2f(p0[r]);
}
__device__ __forceinline__ void scoreMid(f32x16& p0, f32x16& p1, float& m_reg, float& mn, float& alpha, int kq, const float* tb, int r32, int hi) {
  constexpr float C = 0.125f * LOG2E;
  const float* tp = tb + (kq + 256 - r32 + 4 * hi);
#pragma unroll
  for (int r = 0; r < 16; ++r) { const int e = (r & 3) + 8 * (r >> 2);
    p0[r] += tp[e]; p1[r] += tp[e + 32];
    if ((r & 3) == 3) asm volatile("" ::: "memory"); }
  const float pmax = rowmax32(p0, p1);
  decide(pmax, m_reg, mn, alpha);
#pragma unroll
  for (int r = 0; r < 16; ++r) { p0[r] -= mn; p1[r] -= mn; }
#pragma unroll
  for (int r = 0; r < 16; ++r) p0[r] = __builtin_amdgcn_exp2f(p0[r]);
}
__device__ __forceinline__ void scoreSM1(f32x16& p0, f32x16& p1, float& m_reg, float& mn, float& alpha, const float* rpr, const float (&pen0)[16], const float (&pen1)[16]) {
  constexpr float C = 0.08838834764831845f * LOG2E;
#pragma unroll
  for (int r = 0; r < 16; ++r) { const int e = (r & 3) + 8 * (r >> 2);
    p0[r] += rpr[e] + pen0[r]; p1[r] += rpr[e + 32] + pen1[r];
    if ((r & 3) == 3) asm volatile("" ::: "memory"); }
  const float pmax = rowmax32(p0, p1);
  decide(pmax, m_reg, mn, alpha);
#pragma unroll
  for (int r = 0; r < 16; ++r) { p0[r] -= mn; p1[r] -= mn; }
#pragma unroll
  for (int r = 0; r < 16; ++r) p0[r] = __builtin_amdgcn_exp2f(p0[r]);
}
__device__ __forceinline__ void finishSM(f32x16& p0, f32x16& p1, float alpha, float& l_reg, bf16x8& pa0, bf16x8& pa1, bf16x8& pa2, bf16x8& pa3) {
#pragma unroll
  for (int r = 0; r < 16; ++r) p1[r] = __builtin_amdgcn_exp2f(p1[r]);
  float ps = 0;
#pragma unroll
  for (int r = 0; r < 16; ++r) ps += p0[r];
#pragma unroll
  for (int r = 0; r < 16; ++r) ps += p1[r];
  { auto rr = __builtin_amdgcn_permlane32_swap(__float_as_uint(ps), __float_as_uint(ps), false, false);
    ps = __uint_as_float(rr[0]) + __uint_as_float(rr[1]); }
  l_reg = l_reg * alpha + ps;
#define PK4(P, BASE, OUT) do { unsigned a0 = cvtpk(P[BASE + 0], P[BASE + 1]), a1 = cvtpk(P[BASE + 2], P[BASE + 3]);   \
    unsigned b0 = cvtpk(P[BASE + 4], P[BASE + 5]), b1 = cvtpk(P[BASE + 6], P[BASE + 7]);                              \
    auto r0 = __builtin_amdgcn_permlane32_swap(a0, b0, false, false); auto r1 = __builtin_amdgcn_permlane32_swap(a1, b1, false, false); \
    u32x4 w = {r0[0], r1[0], r0[1], r1[1]}; OUT = *reinterpret_cast<bf16x8*>(&w); } while (0)
  PK4(p0, 0, pa0); PK4(p0, 8, pa1); PK4(p1, 0, pa2); PK4(p1, 8, pa3);
#undef PK4
}
template <int NQ> __device__ __forceinline__ void qkt(f32x16& p0, f32x16& p1, const char* Ks, const bf16x8* qr, int r32, int hi, int kcolB) {
  p0 = f32x16{}; p1 = f32x16{};
#pragma unroll
  for (int d0 = 0; d0 < NQ; ++d0) { const int cb = kcolB + (d0 * 16 + hi * 8) * 2;
    bf16x8 b0 = *reinterpret_cast<const bf16x8*>(Ks + KSWZ(r32, cb));
    bf16x8 b1 = *reinterpret_cast<const bf16x8*>(Ks + KSWZ(32 + r32, cb));
    p0 = __builtin_amdgcn_mfma_f32_32x32x16_bf16(b0, qr[d0], p0, 0, 0, 0);
    p1 = __builtin_amdgcn_mfma_f32_32x32x16_bf16(b1, qr[d0], p1, 0, 0, 0); }
}
__device__ __forceinline__ void qkt0(f32x16& p0, f32x16& p1, const char* Ks, const char* Qs, int r32, int hi, int kcolB, const f32x16& init) {
#pragma unroll
  for (int d0 = 0; d0 < 4; ++d0) { const int cb = kcolB + (d0 * 16 + hi * 8) * 2;
    bf16x8 b0 = *reinterpret_cast<const bf16x8*>(Ks + KSWZ(r32, cb));
    bf16x8 b1 = *reinterpret_cast<const bf16x8*>(Ks + KSWZ(32 + r32, cb));
    bf16x8 qf = *reinterpret_cast<const bf16x8*>(Qs + r32 * 128 + (((2 * d0 + hi) ^ (r32 & 7)) << 4));
    if (d0 == 0) { p0 = __builtin_amdgcn_mfma_f32_32x32x16_bf16(b0, qf, init, 0, 0, 0); p1 = __builtin_amdgcn_mfma_f32_32x32x16_bf16(b1, qf, init, 0, 0, 0); }
    else { p0 = __builtin_amdgcn_mfma_f32_32x32x16_bf16(b0, qf, p0, 0, 0, 0); p1 = __builtin_amdgcn_mfma_f32_32x32x16_bf16(b1, qf, p1, 0, 0, 0); } }
}
__device__ __forceinline__ void qkt_lq(f32x16& p0, f32x16& p1, const char* Ks, const char* Qs, int r32, int hi) {
  p0 = f32x16{}; p1 = f32x16{};
#pragma unroll
  for (int d0 = 0; d0 < 8; ++d0) { const int cb = (d0 * 16 + hi * 8) * 2;
    bf16x8 b0 = *reinterpret_cast<const bf16x8*>(Ks + KSWZ(r32, cb));
    bf16x8 b1 = *reinterpret_cast<const bf16x8*>(Ks + KSWZ(32 + r32, cb));
    bf16x8 qf = *reinterpret_cast<const bf16x8*>(Qs + KSWZ(r32, cb));
    p0 = __builtin_amdgcn_mfma_f32_32x32x16_bf16(b0, qf, p0, 0, 0, 0);
    p1 = __builtin_amdgcn_mfma_f32_32x32x16_bf16(b1, qf, p1, 0, 0, 0);
    if ((d0 & 1) == 1) SBAR(); }
}
__device__ __forceinline__ int v_st(int k, int c) { const int kk = (k & ~0xC) | ((k & 4) << 1) | ((k & 8) >> 1); return ((kk >> 3) * 4 + (c >> 5)) * 512 + ((kk & 7) * 32 + (c & 31)) * 2; }
__device__ __forceinline__ int v_rd_base(int lane) { return ((lane & 3) << 3) | (((lane >> 2) & 3) << 6) | (((lane >> 4) & 1) << 5) | (((lane >> 5) & 1) << 8); }
constexpr int v_rd_off(int d0, int ks, int half) { return d0 * 512 + ks * 4096 + half * 2048; }
template <int OFF> __device__ __forceinline__ s16x4 tr_read(int vb) {
  s16x4 r; asm volatile("ds_read_b64_tr_b16 %0, %1 offset:%2" : "=&v"(r) : "v"(vb), "i"(OFF) : "memory"); return r;
}
template <int D0> __device__ __forceinline__ void rd8(s16x4 (&l)[4], s16x4 (&h)[4], int vb) {
  l[0] = tr_read<v_rd_off(D0, 0, 0)>(vb); h[0] = tr_read<v_rd_off(D0, 0, 1)>(vb); l[1] = tr_read<v_rd_off(D0, 1, 0)>(vb); h[1] = tr_read<v_rd_off(D0, 1, 1)>(vb);
  l[2] = tr_read<v_rd_off(D0, 2, 0)>(vb); h[2] = tr_read<v_rd_off(D0, 2, 1)>(vb); l[3] = tr_read<v_rd_off(D0, 3, 0)>(vb); h[3] = tr_read<v_rd_off(D0, 3, 1)>(vb);
}
__device__ __forceinline__ void mma4(f32x16& od, const s16x4 (&l)[4], const s16x4 (&h)[4], bf16x8 pa0, bf16x8 pa1, bf16x8 pa2, bf16x8 pa3) {
#define PK(L, H) (bf16x8){L[0], L[1], L[2], L[3], H[0], H[1], H[2], H[3]}
  od = __builtin_amdgcn_mfma_f32_32x32x16_bf16(pa0, PK(l[0], h[0]), od, 0, 0, 0);
  od = __builtin_amdgcn_mfma_f32_32x32x16_bf16(pa1, PK(l[1], h[1]), od, 0, 0, 0);
  od = __builtin_amdgcn_mfma_f32_32x32x16_bf16(pa2, PK(l[2], h[2]), od, 0, 0, 0);
  od = __builtin_amdgcn_mfma_f32_32x32x16_bf16(pa3, PK(l[3], h[3]), od, 0, 0, 0);
#undef PK
}
#define WAITDEP(N, l, h) asm volatile("s_waitcnt lgkmcnt(" #N ")" : "+v"(l[0]), "+v"(l[1]), "+v"(l[2]), "+v"(l[3]), "+v"(h[0]), "+v"(h[1]), "+v"(h[2]), "+v"(h[3]) :: "memory")
__device__ __forceinline__ void pv_d0(f32x16* o, int vb, bf16x8 pa0, bf16x8 pa1, bf16x8 pa2, bf16x8 pa3) {
  s16x4 la[4], ha[4];
  rd8<0>(la, ha, vb); WAITDEP(0, la, ha); mma4(o[0], la, ha, pa0, pa1, pa2, pa3);
  rd8<1>(la, ha, vb); WAITDEP(0, la, ha); mma4(o[1], la, ha, pa0, pa1, pa2, pa3);
  rd8<2>(la, ha, vb); WAITDEP(0, la, ha); mma4(o[2], la, ha, pa0, pa1, pa2, pa3);
  rd8<3>(la, ha, vb); WAITDEP(0, la, ha); mma4(o[3], la, ha, pa0, pa1, pa2, pa3);
}
#undef WAITDEP

template <int MODE>
__device__ __forceinline__ void attn_unit(bf16r* P0, const bf16r* __restrict__ PKV, int rowbase, int seqL, int h, int blk, float lam,
                                          const float* __restrict__ subg, const float* __restrict__ tsrc, char* lds) {
  constexpr int NQ = (MODE == 0) ? 4 : 8;
  int tid_ = threadIdx.x; asm volatile("" : "+v"(tid_));
  const int tid = tid_, wid = __builtin_amdgcn_readfirstlane(tid >> 6), lane = tid & 63, r32 = lane & 31, hi = lane >> 5;
  float* ws = (float*)(lds + OFF_WS) + wid * 64; float* li_l = ws; float* al_l = ws + 32;
  float* tb = (float*)(lds + OFF_TB);
  int qrow, kcolB, tbase, NT, colbase, gr = 0, rs = 0, qc = 0, cmap = 0;
  float bL = 0.f, bR = 0.f;
  if constexpr (MODE == 0) {
    cmap = wid >> 2; qrow = blk * 128 + (wid & 3) * 32; kcolB = cmap * 128; tbase = 0; NT = seqL / KVBLK; colbase = h * 128;
    bL = tsrc[15 * 8 + h] * LOG2E; bR = tsrc[31 * 8 + h] * LOG2E;
    { const int rel = tid - 256, n = rel < 0 ? -rel : rel;
      int bk = n < 8 ? n : min(15, 8 + (31 - __clz((n * n) >> 6))); if (rel > 0) bk += 16;
      tb[tid] = tsrc[bk * 8 + h] * LOG2E; }
  } else {
    const int rows = seqL / 64; qrow = blk * 256 + wid * 32; kcolB = 0; colbase = 1024 + h * 128; NT = 12;
    const int rs0 = min(max(blk * 4 - 4, 0), rows - 8); tbase = min(rs0, rows - 12);
    gr = blk * 4 + (wid >> 1); rs = min(max(gr - 4, 0), rows - 8); qc = (wid & 1) * 32 + r32;
    for (int i = tid; i < 15 * 128; i += 512) { const int dr = i >> 7, dc = (i & 127) - 48; tb[i] = (dc >= 0 && dc < 31) ? tsrc[(h * 15 + dr) * 31 + dc] * LOG2E : 0.f; }
  }
  const bf16r* Qw = P0 + (size_t)(rowbase + qrow + r32) * LD + colbase + (MODE == 0 ? cmap * 64 : 0) + hi * 8;
  const bf16r* Kh = PKV + (size_t)rowbase * LD + h * 128; const bf16r* Vh = Kh + 1024;
  float m_reg = -1e30f, l_reg = 0; f32x16 o[4] = {};
  char* Qs = (MODE == 0) ? lds + OFF_STG_HI + wid * 4096 : lds + stg_off(wid);
  if constexpr (MODE == 0) {
#pragma unroll
    for (int d0 = 0; d0 < 4; ++d0) { const bf16x8 qv = ld8(Qw + d0 * 16); *(bf16x8*)(Qs + r32 * 128 + (((2 * d0 + hi) ^ (r32 & 7)) << 4)) = qv; }
  } else {
#pragma unroll
    for (int d0 = 0; d0 < 8; ++d0) { const bf16x8 qv = ld8(Qw + d0 * 16); *(bf16x8*)(Qs + KSWZ(r32, (d0 * 16 + hi * 8) * 2)) = qv; }
  }
  const int sr = tid >> 4, sc = (tid & 15) * 8, vst0 = v_st(sr, sc), vst1 = v_st(32 + sr, sc);
  const int vb0 = (int)(uintptr_t)lds + v_rd_base(lane);
  struct { bf16x8 vs0, vs1, ks0, ks1; } sr_[1];
#define KOFF(t) ((tbase + (t)) * KVBLK)
#define SLOAD(i, k0) do { sr_[i].vs0 = ld8(&Vh[(size_t)((k0) + sr) * LD + sc]); sr_[i].vs1 = ld8(&Vh[(size_t)((k0) + 32 + sr) * LD + sc]); \
    sr_[i].ks0 = ld8(&Kh[(size_t)((k0) + sr) * LD + sc]); sr_[i].ks1 = ld8(&Kh[(size_t)((k0) + 32 + sr) * LD + sc]); } while (0)
#define SWRITE(soff, i) do { char* sb_ = lds + (soff); *(bf16x8*)(sb_ + vst0) = sr_[i].vs0;          \
    *(bf16x8*)(sb_ + vst1) = sr_[i].vs1; int kc_ = sc * 2;               \
    *(bf16x8*)(sb_ + SLOT_K + KSWZ(sr, kc_)) = sr_[i].ks0;                       \
    *(bf16x8*)(sb_ + SLOT_K + KSWZ(32 + sr, kc_)) = sr_[i].ks1; } while (0)
#define SWAIT() asm volatile("s_waitcnt vmcnt(0)" ::: "memory")
#define RESC(a) do { if (__any((a) < 1.f)) { if (hi == 0) al_l[r32] = (a); asm volatile("s_waitcnt lgkmcnt(0)" ::: "memory"); \
    _Pragma("unroll") for (int d = 0; d < 4; ++d) _Pragma("unroll") for (int r = 0; r < 16; ++r) o[d][r] *= al_l[crow(r, hi)]; } } while (0)
  bf16x8 pa0, pa1, pa2, pa3;
  if constexpr (MODE == 0) {
    const int tm0 = max(2 * blk - 2, 0), tm1 = min(2 * blk + 4, NT), nmid = tm1 - tm0, NH = NT - nmid;
    {
      f32x16 pM0, pM1; float mnM, alM; f32x16 zinit = {};
      SLOAD(0, KOFF(tm0)); asm volatile("s_waitcnt vmcnt(0)" ::: "memory"); SWRITE(0, 0); __syncthreads();
#pragma nounroll
      for (int t = 0; t < nmid; ++t) {
        const int so = (t & 1) * SLOT;
        if (t + 1 < nmid) SLOAD(0, KOFF(tm0 + t + 1));
        SBAR(); qkt0(pM0, pM1, lds + so + SLOT_K, Qs, r32, hi, kcolB, zinit);
        scoreMid(pM0, pM1, m_reg, mnM, alM, KOFF(tm0 + t) - qrow, tb, r32, hi); RESC(alM);
        finishSM(pM0, pM1, alM, l_reg, pa0, pa1, pa2, pa3); SBAR();
        pv_d0(o, vb0 + so, pa0, pa1, pa2, pa3); SBAR();
        if (t + 1 < nmid) { SWAIT(); SWRITE(SLOT - so, 0); }
        __syncthreads();
      }
    }
    f32x16 pA0, pA1, pB0, pB1; float mnA, mnB, alA, alB;
#define HT(i) ((i) < tm0 ? (i) : (i) + nmid)
#define CB(i) ((i) < tm0 ? bL : bR)
    SLOAD(0, KOFF(HT(0))); asm volatile("s_waitcnt vmcnt(0)" ::: "memory"); SWRITE(0, 0);
    SLOAD(0, KOFF(HT(1))); asm volatile("s_waitcnt vmcnt(0)" ::: "memory"); SWRITE(SLOT, 0);
    SLOAD(0, KOFF(HT(2)));
    __syncthreads();
    f32x16 negm;
#define NEGM(i) do { const float nv_ = CB(i) - m_reg; if (__any(nv_ != negm[0])) { _Pragma("unroll") for (int r = 0; r < 16; ++r) negm[r] = nv_; asm volatile("" : "+v"(negm)); } } while (0)
    { const float nv_ = CB(0) - m_reg; _Pragma("unroll") for (int r = 0; r < 16; ++r) negm[r] = nv_; asm volatile("" : "+v"(negm)); }
    qkt0(pA0, pA1, lds + SLOT_K, Qs, r32, hi, kcolB, negm); scoreConst(pA0, pA1, m_reg, alA);
    int sPrev = 0, sCur = SLOT, sNext = 2 * SLOT;
#define ROT() do { const int t_ = sPrev; sPrev = sCur; sCur = sNext; sNext = t_; } while (0)
#define STEP(PX0, PX1, MNX, ALX, PY0, PY1, ALY, i) do { \
      NEGM(i); SBAR(); qkt0(PX0, PX1, lds + sCur + SLOT_K, Qs, r32, hi, kcolB, negm); \
      finishSM(PY0, PY1, ALY, l_reg, pa0, pa1, pa2, pa3); SBAR(); \
      pv_d0(o, vb0 + sPrev, pa0, pa1, pa2, pa3); \
      SWAIT(); SWRITE(sNext, 0); { const int tn_ = min((i) + 2, NH - 1); SLOAD(0, KOFF(HT(tn_))); } \
      scoreConst(PX0, PX1, m_reg, ALX); SBAR(); \
      RESC(ALX); ROT(); __syncthreads(); } while (0)
    for (int j = 1; j + 1 < NH; j += 2) {
      STEP(pB0, pB1, mnB, alB, pA0, pA1, alA, j);
      STEP(pA0, pA1, mnA, alA, pB0, pB1, alB, j + 1);
    }
    NEGM(NH - 1); SBAR(); qkt0(pB0, pB1, lds + sCur + SLOT_K, Qs, r32, hi, kcolB, negm);
    finishSM(pA0, pA1, alA, l_reg, pa0, pa1, pa2, pa3); SBAR();
    pv_d0(o, vb0 + sPrev, pa0, pa1, pa2, pa3); scoreConst(pB0, pB1, m_reg, alB); SBAR();
    RESC(alB);
    finishSM(pB0, pB1, alB, l_reg, pa0, pa1, pa2, pa3); SBAR();
    pv_d0(o, vb0 + sCur, pa0, pa1, pa2, pa3);
#undef ROT
#undef STEP
#undef NEGM
#undef HT
#undef CB
  } else {
    f32x16 pA0, pA1; float mnA, alA;
    float pen0[16], pen1[16];
    { const int cs = min(max(qc - 8, 0), 48);
#pragma unroll
      for (int r = 0; r < 16; ++r) { const int kc = (r & 3) + 8 * (r >> 2) + 4 * hi;
        pen0[r] = ((unsigned)(kc - cs) < 16u) ? 0.f : -1e30f; pen1[r] = ((unsigned)(kc + 32 - cs) < 16u) ? 0.f : -1e30f; } }
    const float* rpl = tb + (4 * hi - qc + 63);
    SLOAD(0, KOFF(0)); asm volatile("s_waitcnt vmcnt(0)" ::: "memory"); SWRITE(0, 0); __syncthreads();
#pragma nounroll
    for (int t = 0; t < NT; ++t) {
      const int b = t & 1;
      if (t + 1 < NT) SLOAD(0, KOFF(t + 1));
      if ((unsigned)(tbase + t - rs) < 8u) {
        int ln_ = lane; asm volatile("" : "+v"(ln_)); const int r32v = ln_ & 31, hiv = ln_ >> 5;
        SBAR(); qkt_lq(pA0, pA1, lds + b * SLOT + SLOT_K, Qs, r32v, hiv);
        scoreSM1(pA0, pA1, m_reg, mnA, alA, rpl + (tbase + t - gr + 7) * 128, pen0, pen1); RESC(alA);
        finishSM(pA0, pA1, alA, l_reg, pa0, pa1, pa2, pa3); SBAR();
        pv_d0(o, vb0 + b * SLOT, pa0, pa1, pa2, pa3); SBAR();
      }
      if (t + 1 < NT) { SWAIT(); SWRITE(SLOT - b * SLOT, 0); }
      __syncthreads();
    }
  }
  if (hi == 0) li_l[r32] = l_reg; asm volatile("s_waitcnt lgkmcnt(0)" ::: "memory");
  float rli[16];
#pragma unroll
  for (int r = 0; r < 16; ++r) rli[r] = __builtin_amdgcn_rcpf(li_l[crow(r, hi)]);
  bf16r* stg = (bf16r*)(lds + stg_off(wid));
  bf16r* Ow = P0 + (size_t)(rowbase + qrow) * LD + colbase;
  __syncthreads();
  if constexpr (MODE == 0) {
    float* X = (float*)lds + (wid & 3) * 4096;
    if (cmap == 1) {
#pragma unroll
      for (int d0 = 0; d0 < 4; ++d0)
#pragma unroll
        for (int r = 0; r < 16; ++r) X[(d0 * 16 + r) * 64 + lane] = o[d0][r] * rli[r] * lam;
    }
    __syncthreads();
    if (cmap == 0) {
#pragma unroll
      for (int d0 = 0; d0 < 4; ++d0)
#pragma unroll
        for (int r = 0; r < 16; ++r) o[d0][r] = o[d0][r] * rli[r] - X[(d0 * 16 + r) * 64 + lane];
      float gc[4];
#pragma unroll
      for (int d0 = 0; d0 < 4; ++d0) gc[d0] = subg[d0 * 32 + r32] * 0.8f;
#pragma unroll
      for (int r = 0; r < 16; ++r) { float ss = (o[0][r] * o[0][r] + o[1][r] * o[1][r]) + (o[2][r] * o[2][r] + o[3][r] * o[3][r]);
        ss += __shfl_xor(ss, 1); ss += __shfl_xor(ss, 2); ss += __shfl_xor(ss, 4); ss += __shfl_xor(ss, 8); ss += __shfl_xor(ss, 16);
        const float rinv = __builtin_amdgcn_rsqf(ss * (1.0f / 128.0f) + 1e-6f); const int orow = crow(r, hi);
#pragma unroll
        for (int d0 = 0; d0 < 4; ++d0) stg[orow * 128 + d0 * 32 + r32] = (bf16r)(cvtpk(o[d0][r] * rinv * gc[d0], 0.f) & 0xffffu); }
      asm volatile("s_waitcnt lgkmcnt(0)" ::: "memory");
#pragma unroll
      for (int i = 0; i < 8; ++i) { const int row = i * 4 + (lane >> 4), ch = lane & 15; const u32x4 v = *(const u32x4*)(stg + row * 128 + ch * 8); *(u32x4*)(Ow + (size_t)row * LD + ch * 8) = v; }
    }
  } else {
#pragma unroll
    for (int r = 0; r < 16; ++r) { const int orow = crow(r, hi);
#pragma unroll
      for (int d0 = 0; d0 < 4; ++d0) stg[orow * 128 + d0 * 32 + r32] = (bf16r)(cvtpk(o[d0][r] * rli[r], 0.f) & 0xffffu); }
    asm volatile("s_waitcnt lgkmcnt(0)" ::: "memory");
#pragma unroll
    for (int i = 0; i < 8; ++i) { const int row = i * 4 + (lane >> 4), ch = lane & 15; const u32x4 v = *(const u32x4*)(stg + row * 128 + ch * 8); *(u32x4*)(Ow + (size_t)row * LD + ch * 8) = v; }
  }
  __syncthreads();
#undef KOFF
#undef SLOAD
#undef SWRITE
#undef SWAIT
#undef RESC
}
#undef SBAR
}

namespace cg = cooperative_groups;
#define LAS __attribute__((address_space(3)))
typedef unsigned short bf16;
typedef unsigned v4u __attribute__((ext_vector_type(4)));
typedef float f32x4 __attribute__((ext_vector_type(4)));
constexpr int NWAVES = 8;
constexpr int MTOK = 32768, MP = 16384, DMODEL = 2048, NIN = 6144, DFF = 5504, NUP = 11008;
constexpr float EPS = 1e-6f;
constexpr size_t MiB = 1u << 20;
constexpr size_t WS_BAR = 512 * 1024, WS_BAR_BYTES = 16384;
constexpr size_t WS_SS2 = 0, WS_SS3 = 1 * MiB, WS_WIN = 5 * MiB, WS_WOUT = 29 * MiB, WS_WUP = 37 * MiB, WS_WDN = 80 * MiB;
constexpr size_t WS_P0 = 102 * MiB, WS_P1 = 230 * MiB, WS_P2 = 358 * MiB, WS_END = 486 * MiB;
constexpr size_t WS_U = WS_P0, WS_EP = WS_P0 + 172 * MiB, WS_EA = WS_EP + 11 * MiB, WS_EG = WS_EA + 11 * MiB;
static_assert((size_t)MP * DFF * 2 <= 172 * MiB && (size_t)512 * DFF * 4 <= 11 * MiB && WS_EG + 11 * MiB <= WS_P2, "FFN overlay");
constexpr int LDS_BYTES = 147456;
static_assert(att::ATT_LDS <= LDS_BYTES - 16 && pg8::STAGE_BYTES <= LDS_BYTES - 16, "LDS map");

__device__ __forceinline__ unsigned cvt_pk(float lo, float hi) { unsigned r; asm volatile("v_cvt_pk_bf16_f32 %0, %1, %2" : "=v"(r) : "v"(lo), "v"(hi)); return r; }
__device__ __forceinline__ float wave_sum(float v) {
#pragma unroll
    for (int o = 1; o < 64; o <<= 1) v += __shfl_xor(v, o);
    return v;
}
struct TItem { const float* src; bf16* dst; const float* g; int N, K; };
__device__ __forceinline__ void item_load(const TItem& t, float (&v)[32], int lane) {
#pragma unroll
    for (int i = 0; i < 32; ++i) v[i] = t.src[(size_t)(2 * i + (lane >> 5)) * t.N + (lane & 31)];
}
__device__ __forceinline__ void item_store(const TItem& t, const float (&v)[32], LAS float* scr, int lane) {
#pragma unroll
    for (int i = 0; i < 32; ++i) scr[(2 * i + (lane >> 5)) * 33 + (lane & 31)] = v[i];
    asm volatile("s_waitcnt lgkmcnt(0)" ::: "memory");
    const int c = lane & 7;
    f32x4 g0 = {1.f, 1.f, 1.f, 1.f}, g1 = g0;
    if (t.g) { g0 = *(const f32x4*)(t.g + 8 * c); g1 = *(const f32x4*)(t.g + 8 * c + 4); }
#pragma unroll
    for (int j = 0; j < 4; ++j) { const int n = (lane >> 3) + 8 * j; const LAS float* sp = scr + (8 * c) * 33 + n;
        v4u o; o.x = cvt_pk(sp[0 * 33] * g0[0], sp[1 * 33] * g0[1]); o.y = cvt_pk(sp[2 * 33] * g0[2], sp[3 * 33] * g0[3]);
        o.z = cvt_pk(sp[4 * 33] * g1[0], sp[5 * 33] * g1[1]); o.w = cvt_pk(sp[6 * 33] * g1[2], sp[7 * 33] * g1[3]);
        *(v4u*)(t.dst + (size_t)n * t.K + 8 * c) = o; }
    asm volatile("s_waitcnt lgkmcnt(0)" ::: "memory");
}

#define XB_TMO      128
#define XB_XCNT(j)  (256  + 64 * (j))
#define XB_XSUB(j)  (1280 + 64 * (j))
#define XB_XGEN(j)  (2304 + 64 * (j))
#define XB_TOP      3328
#define XB_TOPGEN   3392
#define XCD_BAR_WORDS 3456
#define XB_SPIN_CAP (1u << 22)

__device__ __forceinline__ unsigned xb_ld(unsigned* p)              { return __hip_atomic_load(p, __ATOMIC_RELAXED, __HIP_MEMORY_SCOPE_AGENT); }
__device__ __forceinline__ unsigned xb_add(unsigned* p, unsigned v) { return __hip_atomic_fetch_add(p, v, __ATOMIC_RELAXED, __HIP_MEMORY_SCOPE_AGENT); }
__device__ __forceinline__ unsigned xb_xcc_id() { return (unsigned)__builtin_amdgcn_s_getreg((3 << 11) | 20) & 0xFu; }
#define XB_SPIN(cond, bar) do { unsigned _sp = 0; while (cond) { __builtin_amdgcn_s_sleep(1); \
    if ((++_sp & 255u) == 0u) { if (xb_ld(&(bar)[XB_TMO])) break; if (_sp > XB_SPIN_CAP) { atomicAdd(&(bar)[XB_TMO], 1u); break; } } } } while (0)

struct XcdBarrier {
    unsigned* bar; unsigned x;
    volatile LAS unsigned* st;
};

__device__ __forceinline__ XcdBarrier xcd_barrier_post(unsigned* bar, volatile LAS unsigned* st) {
    XcdBarrier b; b.bar = bar; b.x = xb_xcc_id(); b.st = st;
    if (threadIdx.x == 0) (void)xb_add(&bar[XB_XCNT(b.x)], 1u);
    return b;
}
__device__ __forceinline__ void xcd_barrier_complete(unsigned* bar, unsigned x, unsigned& nloc, unsigned& nx) {
    const unsigned G = gridDim.x * gridDim.y * gridDim.z;
    unsigned sum, cnt, mine, sp = 0u;
    for (;;) {
        sum = 0u; cnt = 0u; mine = 0u;
#pragma unroll
        for (unsigned j = 0; j < 16; ++j) { const unsigned c = xb_ld(&bar[XB_XCNT(j)]); sum += c; cnt += (c > 0u) ? 1u : 0u; mine = (j == x) ? c : mine; }
        if (sum == G) break;
        __builtin_amdgcn_s_sleep(1);
        if ((++sp & 255u) == 0u) { if (xb_ld(&bar[XB_TMO])) break; if (sp > XB_SPIN_CAP) { atomicAdd(&bar[XB_TMO], 1u); break; } }
    }
    nloc = mine > 0u ? mine : 1u; nx = cnt > 0u ? cnt : 1u;
}

__device__ __forceinline__ void xcd_barrier(const XcdBarrier& b) {
    asm volatile("s_waitcnt vmcnt(0)" ::: "memory");
    __syncthreads();
    if (threadIdx.x == 0) {
        unsigned* bar = b.bar;
        __builtin_amdgcn_s_waitcnt(0);
        unsigned nloc = b.st[0], nx = b.st[1];
        if (nloc == 0u) { xcd_barrier_complete(bar, b.x, nloc, nx); b.st[0] = nloc; b.st[1] = nx; }
        const unsigned old = xb_add(&bar[XB_XSUB(b.x)], 1u);
        const unsigned gen = old / nloc;
        if (old + 1u == (gen + 1u) * nloc) {
            __builtin_amdgcn_fence(__ATOMIC_RELEASE, "agent");
            asm volatile("s_waitcnt vmcnt(0)" ::: "memory");
            const unsigned og = xb_add(&bar[XB_TOP], 1u);
            const unsigned tg = og / nx;
            if (og + 1u == (tg + 1u) * nx) xb_add(&bar[XB_TOPGEN], 1u);
            else XB_SPIN(xb_ld(&bar[XB_TOPGEN]) == tg, bar);
            __builtin_amdgcn_fence(__ATOMIC_ACQUIRE, "agent");
            xb_add(&bar[XB_XGEN(b.x)], 1u);
            asm volatile("s_waitcnt vmcnt(0)" ::: "memory");
        } else {
            XB_SPIN(xb_ld(&bar[XB_XGEN(b.x)]) == gen, bar);
            __builtin_amdgcn_fence(__ATOMIC_ACQUIRE, "agent");
            asm volatile("s_waitcnt vmcnt(0)" ::: "memory");
        }
    }
    __syncthreads();
}

struct Args {
    const float* x_prompt; const float* x_sample; const float* w_in; const float* w_out; const float* norm1_g; const float* norm2_g; const float* final_g;
    const float* lq1; const float* lk1; const float* lq2; const float* lk2; const float* subln_g; const float* rel_tab; const float* na_rpb;
    const float* w_up; const float* conv_w; const float* conv_b; const float* w_down;
    float* out; unsigned char* ws;
};

__global__ void __launch_bounds__(NWAVES * 64, 2) mk_fwd(Args a_unused) {
    extern __shared__ __attribute__((aligned(16))) unsigned char lds[];
    cg::grid_group grid = cg::this_grid();
    const int tid = threadIdx.x, lane = tid & 63, wave = __builtin_amdgcn_readfirstlane(tid >> 6);
    const int G = gridDim.x, bx = blockIdx.x;
    const int vcu = (G % 8 == 0) ? (bx % 8) * (G / 8) + bx / 8 : bx;
#define LOADARGS() const __attribute__((address_space(4))) Args* ap_ = (const __attribute__((address_space(4))) Args*)__builtin_amdgcn_kernarg_segment_ptr(); asm volatile("" : "+s"(ap_)); \
    const __attribute__((address_space(4))) Args& a = *ap_; unsigned char* const ws = a.ws; (void)ws
#define SS2 ((float*)(ws + WS_SS2))
#define SS3 ((float*)(ws + WS_SS3))
#define Win_t ((bf16*)(ws + WS_WIN))
#define Wout_t ((bf16*)(ws + WS_WOUT))
#define Wup_t ((bf16*)(ws + WS_WUP))
#define Wdn_t ((bf16*)(ws + WS_WDN))
#define P0 ((bf16*)(ws + WS_P0))
#define P1 ((bf16*)(ws + WS_P1))
#define P2 ((bf16*)(ws + WS_P2))
#define XN1 ((bf16*)a.out)
#define XN2 P2
#define U ((bf16*)(ws + WS_U))
#define EP ((float*)(ws + WS_EP))
#define EA ((float*)(ws + WS_EA))
#define EG ((float*)(ws + WS_EG))
    LAS unsigned char* ldsl = (LAS unsigned char*)lds;
    volatile LAS unsigned* bst = (volatile LAS unsigned*)(ldsl + LDS_BYTES - 16);
    if (tid < 2) bst[tid] = 0u;
    __syncthreads();
#define GSYNC() do { LOADARGS(); XcdBarrier b_; b_.bar = (unsigned*)(ws + WS_BAR); b_.x = xb_xcc_id(); b_.st = (volatile LAS unsigned*)(ldsl + LDS_BYTES - 16); xcd_barrier(b_); } while (0)
    const int gw = vcu * NWAVES + wave, NGW = G * NWAVES;

#ifndef PHMASK
#define PHMASK 0xFF
#endif
    if (PHMASK & 1) { LOADARGS();
        LAS float* scr = (LAS float*)(ldsl + wave * 16384);
        constexpr int I_IN = (DMODEL / 64) * (NIN / 32), I_OUT = (DMODEL / 64) * (DMODEL / 32), I_UP = (DMODEL / 64) * (NUP / 32), I_DN = (DFF / 64) * (DMODEL / 32);
        constexpr int NITEMS = I_IN + I_OUT + I_UP + I_DN;
#define DECODE(T, it_) do { int r = (it_); \
            if (r < I_IN) { const int nblk = NIN / 32, kb = r / nblk, nb = r % nblk, n0 = nb * 32, blk = n0 >> 10; \
                  \
                const int oblk = (blk == 0) ? 0 : (blk == 1) ? 2 : (blk == 2) ? 3 : (blk == 3) ? 1 : blk; \
                T.src = a.w_in + (size_t)(kb * 64) * NIN + n0; T.dst = Win_t + (size_t)(oblk * 1024 + (n0 & 1023)) * DMODEL + kb * 64; T.g = a.norm1_g + kb * 64; T.N = NIN; T.K = DMODEL; } \
            else if ((r -= I_IN) < I_OUT) { const int nblk = DMODEL / 32, kb = r / nblk, nb = r % nblk; \
                T.src = a.w_out + (size_t)(kb * 64) * DMODEL + nb * 32; T.dst = Wout_t + (size_t)(nb * 32) * DMODEL + kb * 64; T.g = nullptr; T.N = DMODEL; T.K = DMODEL; } \
            else if ((r -= I_OUT) < I_UP) { const int nblk = NUP / 32, kb = r / nblk, nb = r % nblk, n0 = nb * 32; const int isg = n0 >= DFF ? 1 : 0, j = n0 - isg * DFF; \
                T.src = a.w_up + (size_t)(kb * 64) * NUP + n0; T.dst = Wup_t + (size_t)((j >> 7) * 256 + isg * 128 + (j & 127)) * DMODEL + kb * 64; T.g = a.norm2_g + kb * 64; T.N = NUP; T.K = DMODEL; } \
            else { r -= I_UP; const int nblk = DMODEL / 32, kb = r / nblk, nb = r % nblk; \
                T.src = a.w_down + (size_t)(kb * 64) * DMODEL + nb * 32; T.dst = Wdn_t + (size_t)(nb * 32) * DFF + kb * 64; T.g = nullptr; T.N = DMODEL; T.K = DFF; } } while (0)
        {
            TItem t0, t1; float va[32], vb[32];
            int it = gw;
            if (it < NITEMS) { DECODE(t0, it); item_load(t0, va, lane); }
            for (; it < NITEMS; it += NGW) {
                const int nit = it + NGW; const bool more = nit < NITEMS;
                if (more) { DECODE(t1, nit); item_load(t1, vb, lane); }
                item_store(t0, va, scr, lane);
                if (more) { t0 = t1;
#pragma unroll
                    for (int i = 0; i < 32; ++i) va[i] = vb[i]; }
            }
        }
#undef DECODE
        {
            f32x4 v[8], w[8];
            int m = gw;
#define ROWPTR(m_) ((const f32x4*)(((m_) < MP) ? a.x_prompt + (size_t)(m_) * DMODEL : a.x_sample + (size_t)((m_) - MP) * DMODEL) + 2 * lane)
            if (m < MTOK) { const f32x4* xr = ROWPTR(m);
#pragma unroll
                for (int j = 0; j < 4; ++j) { v[2 * j] = xr[128 * j]; v[2 * j + 1] = xr[128 * j + 1]; } }
            for (; m < MTOK; m += NGW) {
                const int nm = m + NGW; const bool more = nm < MTOK;
                if (more) { const f32x4* xr = ROWPTR(nm);
#pragma unroll
                    for (int j = 0; j < 4; ++j) { w[2 * j] = xr[128 * j]; w[2 * j + 1] = xr[128 * j + 1]; } }
                float sq = 0.f;
#pragma unroll
                for (int j = 0; j < 8; ++j) sq += (v[j].x * v[j].x + v[j].y * v[j].y) + (v[j].z * v[j].z + v[j].w * v[j].w);
                const float rstd = 1.0f / sqrtf(wave_sum(sq) * (1.0f / DMODEL) + EPS);
                v4u* o16 = (v4u*)(XN1 + (size_t)m * DMODEL) + lane;
#pragma unroll
                for (int j = 0; j < 4; ++j) { v4u o; o.x = cvt_pk(v[2 * j].x * rstd, v[2 * j].y * rstd); o.y = cvt_pk(v[2 * j].z * rstd, v[2 * j].w * rstd);
                    o.z = cvt_pk(v[2 * j + 1].x * rstd, v[2 * j + 1].y * rstd); o.w = cvt_pk(v[2 * j + 1].z * rstd, v[2 * j + 1].w * rstd); o16[64 * j] = o; }
                if (more) {
#pragma unroll
                    for (int j = 0; j < 8; ++j) v[j] = w[j]; }
            }
#undef ROWPTR
        }
        for (int i = bx * (NWAVES * 64) + tid; i < MTOK; i += G * NWAVES * 64) SS2[i] = 0.f;
        if (bx == 0) for (int i = tid; i < XCD_BAR_WORDS; i += NWAVES * 64) ((unsigned*)(ws + WS_BAR))[i] = 0u;
    }
    grid.sync();
    { LOADARGS(); (void)xcd_barrier_post((unsigned*)(ws + WS_BAR), bst); }

    if (PHMASK & 2) { LOADARGS();
        pg8::Gemm g{XN1, Win_t, MTOK, NIN, DMODEL}; pg8::StaticOrder S; S.init(MTOK, NIN, G, bx);
        pg8::EpiBf16<0> E{P0, DMODEL, nullptr, DMODEL, (size_t)(WS_P1 - WS_P0) / 2, 0.125f * att::LOG2E, 0.08838834764831845f * att::LOG2E};
        pg8::gemm_phase<pg8::EpiBf16<0>, pg8::StaticOrder, PG8_ALIGN, PG8_SP2>(ldsl, g, S, E);
    }
    GSYNC();

    if (PHMASK & 4) { LOADARGS();
        float s1 = wave_sum(a.lq1[lane] * a.lk1[lane]), s2 = wave_sum(a.lq2[lane] * a.lk2[lane]);
        const float lam = expf(s1) - expf(s2) + 0.2f;
        for (int u = vcu; u < 3072; u += G) {
#ifndef ATTM
#define ATTM 3
#endif
            if (u < 2048) { if (ATTM & 1) {
                int rowbase, seqL, bh, qb;
                if (u < 1024) { bh = u >> 6; qb = u & 63; rowbase = (bh >> 3) * 8192; seqL = 8192; }
                else { const int v = u - 1024; bh = v >> 5; qb = v & 31; rowbase = MP + (bh >> 3) * 4096; seqL = 4096; }
                att::attn_unit<0>(P0, P1, rowbase, seqL, bh & 7, qb, lam, a.subln_g, a.rel_tab, (char*)lds); }
            } else if (ATTM & 2) {
                int rowbase, seqL, bh, rb;
                if (u < 2560) { const int v = u - 2048; bh = v >> 5; rb = v & 31; rowbase = (bh >> 3) * 8192; seqL = 8192; }
                else { const int v = u - 2560; bh = v >> 4; rb = v & 15; rowbase = MP + (bh >> 3) * 4096; seqL = 4096; }
                att::attn_unit<1>(P0, P2, rowbase, seqL, bh & 7, rb, lam, a.subln_g, a.na_rpb, (char*)lds);
            }
        }
    }
    GSYNC();

    if (PHMASK & 8) { LOADARGS();
        pg8::Gemm g{P0, Wout_t, MTOK, DMODEL, DMODEL}; pg8::StaticOrder S; S.init(MTOK, DMODEL, G, bx);
        pg8::EpiOut E{a.x_prompt, a.x_sample, a.out, XN2, SS2};
        pg8::gemm_phase<pg8::EpiOut, pg8::StaticOrder, PG8_ALIGN, PG8_SP2>(ldsl, g, S, E);
    }
    GSYNC();

#pragma unroll
    for (int ch = 0; ch < 2; ++ch) {
        const size_t r0 = (size_t)ch * MP; const int Lseq = ch == 0 ? 8192 : 4096;
        if (PHMASK & 16) { LOADARGS();
            pg8::Gemm g{XN2 + r0 * DMODEL, Wup_t, MP, NUP, DMODEL}; pg8::StaticOrder S; S.init(MP, NUP, G, bx);
            pg8::EpiUp E{U, SS2 + r0, a.conv_w, a.conv_b, EP, EA, EG};
            pg8::gemm_phase<pg8::EpiUp, pg8::StaticOrder, PG8_ALIGN, PG8_SP2>(ldsl, g, S, E);
        }
        GSYNC();
        if (PHMASK & 32) { LOADARGS();
            constexpr int CPR = DFF / 8;
            for (int it = bx * (NWAVES * 64) + tid; it < 512 * CPR; it += G * NWAVES * 64) {
                const int e = it / CPR, j0 = (it % CPR) * 8, side = e & 1, row = (e >> 1) * 64 + (side ? 63 : 0);
                const bool has_nb = side ? (((row + 1) % Lseq) != 0) : ((row % Lseq) != 0);
                const int nb = side ? e + 1 : e - 1;
                const float* wv = a.conv_w + (side ? 2 * DFF : 0) + j0;
                float c[8], gg[8];
#pragma unroll
                for (int k = 0; k < 2; ++k) { const f32x4 p = *(const f32x4*)(EP + (size_t)e * DFF + j0 + 4 * k), g4 = *(const f32x4*)(EG + (size_t)e * DFF + j0 + 4 * k);
                    f32x4 t = p; if (has_nb) { const f32x4 an = *(const f32x4*)(EA + (size_t)nb * DFF + j0 + 4 * k), w4 = *(const f32x4*)(wv + 4 * k); t = p + w4 * an; }
#pragma unroll
                    for (int q = 0; q < 4; ++q) { c[4 * k + q] = t[q]; gg[4 * k + q] = g4[q]; } }
                float uo[8];
#pragma unroll
                for (int k = 0; k < 8; ++k) uo[k] = pg8::gelu_tanh(c[k]) * gg[k];
                v4u w; w.x = cvt_pk(uo[0], uo[1]); w.y = cvt_pk(uo[2], uo[3]); w.z = cvt_pk(uo[4], uo[5]); w.w = cvt_pk(uo[6], uo[7]);
                *(v4u*)(U + (size_t)row * DFF + j0) = w;
            }
        }
        GSYNC();
        if (PHMASK & 64) { LOADARGS();
            pg8::Gemm g{U, Wdn_t, MP, DMODEL, DFF}; pg8::StaticOrder S; S.init(MP, DMODEL, G, bx);
            pg8::EpiDown E{a.out + r0 * DMODEL, SS3 + r0 * 32, XN2 + r0 * DMODEL};
            pg8::gemm_phase<pg8::EpiDown, pg8::StaticOrder, PG8_ALIGN, PG8_SP2>(ldsl, g, S, E);
        }
        GSYNC();
    }

    { LOADARGS();
        int tq_ = threadIdx.x; asm volatile("" : "+v"(tq_)); const int ln = tq_ & 63;
        typedef unsigned v2u __attribute__((ext_vector_type(2)));
        v2u v[8], w[8]; float pp = 0.f, pq = 0.f;
        int m = gw;
        if (m < MTOK) { const v2u* xr = (const v2u*)(XN2 + (size_t)m * DMODEL) + ln; pp = (ln < 32) ? SS3[(size_t)m * 32 + ln] : 0.f;
#pragma unroll
            for (int j = 0; j < 8; ++j) v[j] = xr[64 * j]; }
        for (; m < MTOK; m += NGW) {
            const int nm = m + NGW; const bool more = nm < MTOK;
            if (more) { const v2u* xr = (const v2u*)(XN2 + (size_t)nm * DMODEL) + ln; pq = (ln < 32) ? SS3[(size_t)nm * 32 + ln] : 0.f;
#pragma unroll
                for (int j = 0; j < 8; ++j) w[j] = xr[64 * j]; }
            const float rstd = 1.0f / sqrtf(wave_sum(pp) * (1.0f / DMODEL) + EPS);
            f32x4* xo = (f32x4*)(a.out + (size_t)m * DMODEL) + ln; const f32x4* gr = (const f32x4*)a.final_g + ln;
#pragma unroll
            for (int j = 0; j < 8; ++j) { const f32x4 x0 = {__uint_as_float(v[j].x << 16), __uint_as_float(v[j].x & 0xffff0000u), __uint_as_float(v[j].y << 16), __uint_as_float(v[j].y & 0xffff0000u)};
                xo[64 * j] = x0 * rstd * gr[64 * j]; }
            if (more) { pp = pq;
#pragma unroll
                for (int j = 0; j < 8; ++j) v[j] = w[j]; }
        }
    }
}

#undef LOADARGS
#undef SS2
#undef SS3
#undef Win_t
#undef Wout_t
#undef Wup_t
#undef Wdn_t
#undef P0
#undef P1
#undef P2
#undef XN1
#undef XN2
#undef U
#undef EP
#undef EA
#undef EG

extern "C" void kernel_launch(void* const* d_in, const int* in_sizes, int n_in, void* d_out, int out_size, void* d_ws, size_t ws_size, hipStream_t stream) {
    static int grid = 0;
    if (grid == 0) {
        if (n_in != 18 || in_sizes[0] != MP * DMODEL || in_sizes[1] != MP * DMODEL || out_size != MTOK * DMODEL || ws_size < WS_END) {
            fprintf(stderr, "kernel_launch: unexpected shapes / workspace (n_in %d, ws %zu, need %zu); nothing launched\n", n_in, ws_size, (size_t)WS_END); grid = -1; return; }
        int dev = 0, cus = 0, per_cu = 0;
        if (hipGetDevice(&dev) != hipSuccess || hipDeviceGetAttribute(&cus, hipDeviceAttributeMultiprocessorCount, dev) != hipSuccess) { grid = -1; return; }
        if (hipFuncSetAttribute((const void*)mk_fwd, hipFuncAttributeMaxDynamicSharedMemorySize, LDS_BYTES) != hipSuccess) { fprintf(stderr, "kernel_launch: hipFuncSetAttribute failed\n"); grid = -1; return; }
        if (hipOccupancyMaxActiveBlocksPerMultiprocessor(&per_cu, (const void*)mk_fwd, NWAVES * 64, LDS_BYTES) != hipSuccess || per_cu < 1) { fprintf(stderr, "kernel_launch: occupancy query says %d\n", per_cu); per_cu = 1; }
        (void)hipGetLastError();
        grid = cus * 1;
    }
    if (grid < 0) return;
    Args a{};
    a.x_prompt = (const float*)d_in[0]; a.x_sample = (const float*)d_in[1]; a.w_in = (const float*)d_in[2]; a.w_out = (const float*)d_in[3];
    a.norm1_g = (const float*)d_in[4]; a.norm2_g = (const float*)d_in[5]; a.final_g = (const float*)d_in[6];
    a.lq1 = (const float*)d_in[7]; a.lk1 = (const float*)d_in[8]; a.lq2 = (const float*)d_in[9]; a.lk2 = (const float*)d_in[10];
    a.subln_g = (const float*)d_in[11]; a.rel_tab = (const float*)d_in[12]; a.na_rpb = (const float*)d_in[13];
    a.w_up = (const float*)d_in[14]; a.conv_w = (const float*)d_in[15]; a.conv_b = (const float*)d_in[16]; a.w_down = (const float*)d_in[17];
    a.out = (float*)d_out; a.ws = (unsigned char*)d_ws;
    void* args[] = {&a};
    const hipError_t le = hipLaunchCooperativeKernel((const void*)mk_fwd, dim3(grid), dim3(NWAVES * 64), args, LDS_BYTES, stream);
    if (le != hipSuccess) fprintf(stderr, "kernel_launch: cooperative launch failed: %s (grid %d)\n", hipGetErrorName(le), grid);
}
```

```cpp
#include <hip/hip_runtime.h>
#include <hip/hip_cooperative_groups.h>
#include <cstdio>
#include <cstdint>
namespace pg8 {
#define PG8_LAS __attribute__((address_space(3)))
typedef unsigned short bf16_t;
typedef short bf16x8 __attribute__((ext_vector_type(8)));
typedef float f32x4 __attribute__((ext_vector_type(4)));
typedef unsigned u32x4 __attribute__((ext_vector_type(4)));
constexpr int BM = 256, BK = 64, HALF = 128, HTB = HALF * BK * 2  , STAGE_BYTES = 8 * HTB, NXCD = 8, WGM = 4;

__host__ __device__ __forceinline__ int lds_byte(int r, int c) { const int st = (r >> 4) * 2 + (c >> 5), rr = r & 15, cc = c & 31, ob = rr * 64 + cc * 2; return st * 1024 + (ob ^ (((ob >> 9) & 1) << 5)); }
__host__ __device__ __forceinline__ void stage_rc(int b, int& R, int& C) { const int st = b / 1024, sb = b % 1024, swz = sb ^ (((sb >> 9) & 1) << 5); R = (st >> 1) * 16 + swz / 64; C = (st & 1) * 32 + (swz % 64) / 2; }
__host__ __device__ __forceinline__ int perm32(int rho) { const int n = rho >> 4, i = rho & 15; return 8 * (i >> 2) + 4 * n + (i & 3); }

struct Unit { int pm, pn; };
struct Gemm { const bf16_t* A; const bf16_t* Bt; int M, N, K; };

struct StaticOrder {
    int nM, nN, nwg, G, c;
    __host__ __device__ void init(int M, int N, int G_, int c_) { nM = M / BM; nN = N / BM; nwg = nM * nN; G = G_; c = c_; }
    __host__ __device__ bool next(int i, Unit& u) const {
        const long L = (long)i * G + c; if (L >= nwg) return false;
        int wgid = (int)L; { const int q = nwg / NXCD, r = nwg % NXCD, xcd = wgid % NXCD, off = wgid / NXCD; wgid = (xcd < r ? xcd * (q + 1) : r * (q + 1) + (xcd - r) * q) + off; }
        const int nig = WGM * nN, gid = wgid / nig, fm = gid * WGM, gsz = (nM - fm) < WGM ? (nM - fm) : WGM;
        u.pm = fm + ((wgid % nig) % gsz); u.pn = (wgid % nig) / gsz; return true;
    }
    __device__ __forceinline__ void a_ready(const Unit&) const {}
    __device__ __forceinline__ void done(const Unit&) const {}
};

__device__ __forceinline__ unsigned cvt_pk_bf16(float lo, float hi) { unsigned r; asm volatile("v_cvt_pk_bf16_f32 %0, %1, %2" : "=v"(r) : "v"(lo), "v"(hi)); return r; }
typedef float f32x2 __attribute__((ext_vector_type(2)));
__device__ __forceinline__ f32x2 gelu_pk(f32x2 v) {
    const f32x2 av = __builtin_elementwise_abs(v), d = av * 0.2316418882f + 1.0f;
    f32x2 t; t.x = __builtin_amdgcn_rcpf(d.x); t.y = __builtin_amdgcn_rcpf(d.y);
    f32x2 q = t * 0.5307027145f + (-0.7265760135f); q = q * t + 0.7107068705f; q = q * t + (-0.142248368f); q = q * t + 0.127414796f; q = q * t;
    const f32x2 s = (v * v) * (-0.72134752044f);
    f32x2 e; e.x = __builtin_amdgcn_exp2f(s.x); e.y = __builtin_amdgcn_exp2f(s.y);
    const f32x2 m = v * (q * e), r = v - m;
    f32x2 o; o.x = v.x < 0.f ? m.x : r.x; o.y = v.y < 0.f ? m.y : r.y; return o;
}

template <int ACT  > struct EpiBf16 {
    static constexpr bool PERM = true, AFTER_DRAIN = false; static_assert(ACT == 0 || ACT == 1, "EpiBf16: ACT is 0 (none) or 1 (gelu_pk)");
    bf16_t* O; int ldc; const float* bias; int split_cols; size_t split_stride; float scale0, scale1;
    __device__ __forceinline__ void operator()(const f32x4 (&acc)[2][2][4][2], const Unit& u, int wr, int wc, int fr, int fq) const {
        const int row0 = u.pm * BM + wr * 64 + fr; int colt = u.pn * BM; bf16_t* base = O;
        float sc = 1.f; if (split_cols) { const int t = colt / split_cols; base += (size_t)t * split_stride; colt -= t * split_cols; if (t == 0) sc = colt < 1024 ? scale0 : scale1; }
        const int col0 = colt + wc * 32 + 8 * fq, bcol0 = u.pn * BM + wc * 32 + 8 * fq;
        f32x4 bv[2][2];
#pragma unroll
        for (int bj = 0; bj < 2; ++bj)
#pragma unroll
            for (int n = 0; n < 2; ++n) bv[bj][n] = bias ? *(const f32x4*)(bias + bcol0 + bj * HALF + 4 * n) : (f32x4){0.f, 0.f, 0.f, 0.f};
#pragma unroll
        for (int ai = 0; ai < 2; ++ai)
#pragma unroll
            for (int m = 0; m < 4; ++m) { bf16_t* rowp = base + (size_t)(row0 + ai * HALF + m * 16) * ldc + col0;
#pragma unroll
                for (int bj = 0; bj < 2; ++bj) { f32x4 v0 = acc[ai][bj][m][0] + bv[bj][0], v1 = acc[ai][bj][m][1] + bv[bj][1];
                    if (ACT == 1) { f32x2 a = gelu_pk((f32x2){v0[0], v0[1]}), b = gelu_pk((f32x2){v0[2], v0[3]}), c = gelu_pk((f32x2){v1[0], v1[1]}), d = gelu_pk((f32x2){v1[2], v1[3]});
                        v0 = (f32x4){a.x, a.y, b.x, b.y}; v1 = (f32x4){c.x, c.y, d.x, d.y}; }
                    v0 = v0 * sc; v1 = v1 * sc; u32x4 w; w.x = cvt_pk_bf16(v0[0], v0[1]); w.y = cvt_pk_bf16(v0[2], v0[3]); w.z = cvt_pk_bf16(v1[0], v1[1]); w.w = cvt_pk_bf16(v1[2], v1[3]);
                    *(u32x4*)(rowp + bj * HALF) = w; } }
    }
};
typedef unsigned u32x2 __attribute__((ext_vector_type(2)));
constexpr int DM = 2048, DFF = 5504;
__device__ __forceinline__ float gelu_tanh(float x) {
    const float k2 = -2.0f * 0.7978845608028654f * 1.4426950408889634f;
    const float t = x * (1.0f + 0.044715f * x * x);
    const float e = __builtin_amdgcn_exp2f(k2 * t);
    return x * __builtin_amdgcn_rcpf(1.0f + e);
}
struct EpiOut {
    static constexpr bool PERM = true, AFTER_DRAIN = false;
    const float* xp; const float* xs; float* out; bf16_t* xn2; float* ss2;
    __device__ __forceinline__ void operator()(const f32x4 (&acc)[2][2][4][2], const Unit& u, int wr, int wc, int fr, int fq) const {
        const float* xin = (u.pm < 64) ? xp + (size_t)u.pm * (BM * DM) : xs + (size_t)(u.pm - 64) * (BM * DM);
        const int col0 = u.pn * BM + wc * 32 + 8 * fq;
#pragma unroll
        for (int ai = 0; ai < 2; ++ai)
#pragma unroll
            for (int m = 0; m < 4; ++m) { const int rl = ai * HALF + wr * 64 + m * 16 + fr; const size_t R = (size_t)u.pm * BM + rl; float q = 0.f;
#pragma unroll
                for (int bj = 0; bj < 2; ++bj) { const int cc = col0 + bj * HALF;
                    const f32x4 v0 = *(const f32x4*)(xin + (size_t)rl * DM + cc) + acc[ai][bj][m][0], v1 = *(const f32x4*)(xin + (size_t)rl * DM + cc + 4) + acc[ai][bj][m][1];
                    q += ((v0[0] * v0[0] + v0[1] * v0[1]) + (v0[2] * v0[2] + v0[3] * v0[3])) + ((v1[0] * v1[0] + v1[1] * v1[1]) + (v1[2] * v1[2] + v1[3] * v1[3]));
                    u32x4 w; w.x = cvt_pk_bf16(v0[0], v0[1]); w.y = cvt_pk_bf16(v0[2], v0[3]); w.z = cvt_pk_bf16(v1[0], v1[1]); w.w = cvt_pk_bf16(v1[2], v1[3]); *(u32x4*)(xn2 + R * DM + cc) = w; }
                q += __shfl_xor(q, 16); q += __shfl_xor(q, 32);
                if (fq == 0) atomicAdd(ss2 + R, q);
                asm volatile("" ::: "memory"); }
    }
};
struct EpiDown {
    static constexpr bool PERM = true, AFTER_DRAIN = false;
    float* out; float* ss3; bf16_t* res;
    __device__ __forceinline__ void operator()(const f32x4 (&acc)[2][2][4][2], const Unit& u, int wr, int wc, int fr, int fq) const {
        const int col0 = u.pn * BM + wc * 32 + 8 * fq;
#pragma unroll
        for (int ai = 0; ai < 2; ++ai)
#pragma unroll
            for (int m = 0; m < 4; ++m) { const int rl = ai * HALF + wr * 64 + m * 16 + fr; const size_t R = (size_t)u.pm * BM + rl; float q = 0.f;
#pragma unroll
                for (int bj = 0; bj < 2; ++bj) { bf16_t* p = res + R * DM + col0 + bj * HALF;
                    const u32x4 rw = *(const u32x4*)p;
                    const f32x4 r0 = {__uint_as_float(rw.x << 16), __uint_as_float(rw.x & 0xffff0000u), __uint_as_float(rw.y << 16), __uint_as_float(rw.y & 0xffff0000u)};
                    const f32x4 r1 = {__uint_as_float(rw.z << 16), __uint_as_float(rw.z & 0xffff0000u), __uint_as_float(rw.w << 16), __uint_as_float(rw.w & 0xffff0000u)};
                    const f32x4 v0 = r0 + acc[ai][bj][m][0], v1 = r1 + acc[ai][bj][m][1];
                    u32x4 w; w.x = cvt_pk_bf16(v0[0], v0[1]); w.y = cvt_pk_bf16(v0[2], v0[3]); w.z = cvt_pk_bf16(v1[0], v1[1]); w.w = cvt_pk_bf16(v1[2], v1[3]); *(u32x4*)p = w;
                    q += ((v0[0] * v0[0] + v0[1] * v0[1]) + (v0[2] * v0[2] + v0[3] * v0[3])) + ((v1[0] * v1[0] + v1[1] * v1[1]) + (v1[2] * v1[2] + v1[3] * v1[3])); }
                q += __shfl_xor(q, 16); q += __shfl_xor(q, 32);
                if (fq == 0) ss3[R * 32 + u.pn * 4 + wc] = q;
                asm volatile("" ::: "memory"); }
    }
};
struct EpiUp {
    static constexpr bool PERM = true, AFTER_DRAIN = false;
    bf16_t* U; const float* ss2; const float* cw; const float* cb; float* EP; float* EA; float* EG;
    __device__ __forceinline__ void operator()(const f32x4 (&acc)[2][2][4][2], const Unit& u, int wr, int wc, int fr, int fq) const {
        const int j0 = u.pn * 128 + wc * 32 + 8 * fq;
#pragma unroll
        for (int ai = 0; ai < 2; ++ai) {
            const int rb = u.pm * BM + ai * HALF + wr * 64;
            float s[4];
#pragma unroll
            for (int m = 0; m < 4; ++m) s[m] = __builtin_amdgcn_rsqf(ss2[rb + m * 16 + fr] * (1.0f / 2048.0f) + 1e-6f);
            const bool edge = (fr == 0 || fr == 15); u32x2 wl[4];
            const size_t eo = (size_t)(2 * (rb >> 6) + (fr == 15 ? 1 : 0)) * DFF + j0;
#pragma unroll
            for (int n = 0; n < 2; ++n) {
                const f32x4 w0 = *(const f32x4*)(cw + j0 + 4 * n), w1 = *(const f32x4*)(cw + DFF + j0 + 4 * n), w2 = *(const f32x4*)(cw + 2 * DFF + j0 + 4 * n), bb = *(const f32x4*)(cb + j0 + 4 * n);
                f32x4 ec, ea, eg; float uo[4][4];
#pragma unroll
                for (int e = 0; e < 4; ++e) {
                    float a[4], g[4], rp[4], rn[4], cv[4];
#pragma unroll
                    for (int m = 0; m < 4; ++m) { a[m] = acc[ai][0][m][n][e] * s[m]; g[m] = acc[ai][1][m][n][e] * s[m]; }
#pragma unroll
                    for (int m = 0; m < 4; ++m) {
                        rp[m] = __builtin_bit_cast(float, __builtin_amdgcn_update_dpp(0, __builtin_bit_cast(int, a[m]), 0x121, 0xF, 0xF, false));
                        rn[m] = __builtin_bit_cast(float, __builtin_amdgcn_update_dpp(0, __builtin_bit_cast(int, a[m]), 0x12F, 0xF, 0xF, false)); }
#pragma unroll
                    for (int m = 0; m < 4; ++m) {
                        const float pr = (fr > 0) ? rp[m] : (m > 0 ? rp[m > 0 ? m - 1 : 0] : 0.f);
                        const float nx = (fr < 15) ? rn[m] : (m < 3 ? rn[m < 3 ? m + 1 : 3] : 0.f);
                        cv[m] = w0[e] * pr + w1[e] * a[m] + w2[e] * nx + bb[e];
                        uo[m][e] = gelu_tanh(cv[m]) * g[m];
                    }
                    ec[e] = (fr == 0) ? cv[0] : cv[3]; ea[e] = (fr == 0) ? a[0] : a[3]; eg[e] = (fr == 0) ? g[0] : g[3];
                }
                if (edge) { *(f32x4*)(EP + eo + 4 * n) = ec; *(f32x4*)(EA + eo + 4 * n) = ea; *(f32x4*)(EG + eo + 4 * n) = eg; }
#pragma unroll
                for (int m = 0; m < 4; ++m) { u32x2 w; w.x = cvt_pk_bf16(uo[m][0], uo[m][1]); w.y = cvt_pk_bf16(uo[m][2], uo[m][3]);
                    if (n == 0) wl[m] = w; else { u32x4 ww; ww.x = wl[m].x; ww.y = wl[m].y; ww.z = w.x; ww.w = w.y; *(u32x4*)(U + (size_t)(rb + m * 16 + fr) * DFF + j0) = ww; } }
                asm volatile("" ::: "memory");
            }
            asm volatile("" ::: "memory");
        }
    }
};
template <class Epi, class Sched, bool ALIGN_EPI = false, bool SP2 = false>
__device__ __forceinline__ void gemm_phase(PG8_LAS unsigned char* lds, const Gemm g, const Sched& S, const Epi& E) {
    int tid_ = threadIdx.x; asm volatile("" : "+v"(tid_));
    const int tid = tid_, wid = __builtin_amdgcn_readfirstlane(tid >> 6), lane = tid & 63, wr = wid >> 2, wc = wid & 3, fr = lane & 15, fq = lane >> 4;
    const int K = g.K, nt = K / BK;
    unsigned voffA[2], voffB[2];
#pragma unroll
    for (int i = 0; i < 2; ++i) { int R, C; stage_rc(tid * 16 + i * 8192, R, C); const int Rb = Epi::PERM ? ((R & ~31) + perm32(R & 31)) : R;
        voffA[i] = (unsigned)(R * K + C) * 2u; voffB[i] = (unsigned)(Rb * K + C) * 2u; }
    const size_t kstep = (size_t)(BK * 2);
    const size_t hstep = (size_t)HALF * K * 2;
    const size_t tstep = 2 * hstep;
    const unsigned ldsw = (unsigned)wid * 1024u;
    const int aoff = lds_byte(wr * 64 + fr, fq * 8), boff = lds_byte(wc * 32 + fr, fq * 8);
#define PG8_SA(b, h) (((b) * 2 + (h)) * HTB)
#define PG8_SB(b, h) ((4 + (b) * 2 + (h)) * HTB)
#define PG8_STAGE(bufoff, gbase, voff) do { _Pragma("unroll") for (int _i = 0; _i < 2; ++_i) \
        __builtin_amdgcn_global_load_lds((const unsigned*)((const char*)(gbase) + (voff)[_i]), (PG8_LAS unsigned*)(lds + (bufoff) + ldsw + _i * 8192), 16, 0, 0); } while (0)
#define PG8_LDA(dst, b, h) do { _Pragma("unroll") for (int m = 0; m < 4; ++m) _Pragma("unroll") for (int k = 0; k < 2; ++k) dst[m][k] = *(const PG8_LAS bf16x8*)(lds + PG8_SA(b, h) + aoff + m * 2048 + k * 1024); } while (0)
#define PG8_LDB(dst, b, h) do { _Pragma("unroll") for (int n = 0; n < 2; ++n) _Pragma("unroll") for (int k = 0; k < 2; ++k) dst[n][k] = *(const PG8_LAS bf16x8*)(lds + PG8_SB(b, h) + boff + n * 2048 + k * 1024); } while (0)
#define PG8_MMA(ai, bj, At, Bt) do { __builtin_amdgcn_s_setprio(1); _Pragma("unroll") for (int m = 0; m < 4; ++m) _Pragma("unroll") for (int n = 0; n < 2; ++n) _Pragma("unroll") for (int k = 0; k < 2; ++k) \
        acc[ai][bj][m][n] = __builtin_amdgcn_mfma_f32_16x16x32_bf16(Bt[n][k], At[m][k], acc[ai][bj][m][n], 0, 0, 0); __builtin_amdgcn_s_setprio(0); } while (0)
#define PG8_WAIT_V(n) asm volatile("s_waitcnt vmcnt(" #n ")" ::: "memory")
#define PG8_WAIT_L(n) asm volatile("s_waitcnt lgkmcnt(" #n ")" ::: "memory")
#define PG8_BAR __builtin_amdgcn_s_barrier()
#define PG8_SCHED __builtin_amdgcn_sched_barrier(0)
    Unit cur, nxt; int ui = 0;
    if (!S.next(0, cur)) return;
    f32x4 acc[2][2][4][2];
#pragma unroll
    for (int a = 0; a < 2; ++a)
#pragma unroll
        for (int b = 0; b < 2; ++b)
#pragma unroll
            for (int m = 0; m < 4; ++m)
#pragma unroll
                for (int n = 0; n < 2; ++n) acc[a][b][m][n] = (f32x4){0.f, 0.f, 0.f, 0.f};
    bf16x8 At[4][2], B0[2][2], B1[2][2];
    const char* cA = (const char*)g.A + (size_t)cur.pm * tstep; const char* cB = (const char*)g.Bt + (size_t)cur.pn * tstep;
    S.a_ready(cur);
    if constexpr (SP2) {
        PG8_STAGE(PG8_SB(0, 0), cB, voffB); PG8_STAGE(PG8_SB(0, 1), cB + hstep, voffB); PG8_STAGE(PG8_SA(0, 0), cA, voffA); PG8_STAGE(PG8_SA(0, 1), cA + hstep, voffA);
        if (wr == 1) PG8_BAR;
        PG8_WAIT_V(2); PG8_BAR;
        PG8_STAGE(PG8_SB(1, 0), cB + kstep, voffB); PG8_STAGE(PG8_SA(1, 0), cA + kstep, voffA); PG8_STAGE(PG8_SB(1, 1), cB + hstep + kstep, voffB);
        PG8_WAIT_V(6); PG8_BAR;
    } else {
        PG8_STAGE(PG8_SB(0, 0), cB, voffB); PG8_STAGE(PG8_SA(0, 0), cA, voffA); PG8_STAGE(PG8_SB(0, 1), cB + hstep, voffB); PG8_STAGE(PG8_SA(0, 1), cA + hstep, voffA);
        if (wr == 1) PG8_BAR;
        PG8_WAIT_V(4); PG8_BAR;
        PG8_STAGE(PG8_SB(1, 0), cB + kstep, voffB); PG8_STAGE(PG8_SA(1, 0), cA + kstep, voffA); PG8_STAGE(PG8_SB(1, 1), cB + hstep + kstep, voffB);
        PG8_WAIT_V(6); PG8_BAR;
    }
    for (;;) {
        const bool has_next = S.next(ui + 1, nxt);
        const char* nA = has_next ? (const char*)g.A + (size_t)nxt.pm * tstep : cA; const char* nB = has_next ? (const char*)g.Bt + (size_t)nxt.pn * tstep : cB;
        for (int t = 0; t < nt; t += 2) {
            const bool last = (t == nt - 2);
            const char* a1 = cA + (size_t)(t + 1) * kstep;
            const char* a2 = last ? nA : cA + (size_t)(t + 2) * kstep; const char* b2 = last ? nB : cB + (size_t)(t + 2) * kstep;
            const char* a3 = a2 + kstep; const char* b3 = b2 + kstep;
            if (last && has_next) S.a_ready(nxt);
            if constexpr (SP2) {
            PG8_LDB(B0, 0, 0); PG8_LDB(B1, 0, 1); PG8_SCHED; PG8_LDA(At, 0, 0); PG8_STAGE(PG8_SA(1, 1), a1 + hstep, voffA);
            PG8_WAIT_V(8); PG8_WAIT_L(0); PG8_BAR; PG8_MMA(0, 0, At, B0); PG8_MMA(0, 1, At, B1); PG8_BAR; PG8_SCHED;
            PG8_LDA(At, 0, 1); PG8_STAGE(PG8_SB(0, 0), b2, voffB); PG8_STAGE(PG8_SB(0, 1), b2 + hstep, voffB); PG8_STAGE(PG8_SA(0, 0), a2, voffA);
            PG8_WAIT_V(8); PG8_WAIT_L(0); PG8_BAR; PG8_MMA(1, 0, At, B0); PG8_MMA(1, 1, At, B1); PG8_BAR; PG8_SCHED;
            PG8_LDB(B0, 1, 0); PG8_LDB(B1, 1, 1); PG8_SCHED; PG8_LDA(At, 1, 0); PG8_STAGE(PG8_SA(0, 1), a2 + hstep, voffA);
            PG8_WAIT_V(8); PG8_WAIT_L(0); PG8_BAR; PG8_MMA(0, 0, At, B0); PG8_MMA(0, 1, At, B1); PG8_BAR; PG8_SCHED;
            PG8_LDA(At, 1, 1); PG8_STAGE(PG8_SB(1, 0), b3, voffB); PG8_STAGE(PG8_SB(1, 1), b3 + hstep, voffB); PG8_STAGE(PG8_SA(1, 0), a3, voffA);
            PG8_WAIT_V(8); PG8_WAIT_L(0); PG8_BAR; PG8_MMA(1, 0, At, B0); PG8_MMA(1, 1, At, B1); PG8_BAR; PG8_SCHED;
            } else {
            PG8_LDB(B0, 0, 0); PG8_SCHED; PG8_LDA(At, 0, 0); PG8_STAGE(PG8_SA(1, 1), a1 + hstep, voffA);
            PG8_WAIT_L(8); PG8_BAR; PG8_WAIT_L(0); PG8_MMA(0, 0, At, B0); PG8_BAR; PG8_SCHED;
            PG8_LDB(B1, 0, 1); PG8_STAGE(PG8_SB(0, 0), b2, voffB);
            PG8_BAR; PG8_WAIT_L(0); PG8_MMA(0, 1, At, B1); PG8_BAR;
            PG8_LDA(At, 0, 1); PG8_STAGE(PG8_SA(0, 0), a2, voffA);
            PG8_BAR; PG8_WAIT_L(0); PG8_MMA(1, 0, At, B0); PG8_BAR; PG8_SCHED;
            PG8_STAGE(PG8_SB(0, 1), b2 + hstep, voffB);
            PG8_WAIT_V(6); PG8_BAR; PG8_MMA(1, 1, At, B1); PG8_BAR;
            PG8_LDB(B0, 1, 0); PG8_SCHED; PG8_LDA(At, 1, 0); PG8_STAGE(PG8_SA(0, 1), a2 + hstep, voffA);
            PG8_WAIT_L(8); PG8_BAR; PG8_WAIT_L(0); PG8_MMA(0, 0, At, B0); PG8_BAR; PG8_SCHED;
            PG8_LDB(B1, 1, 1); PG8_STAGE(PG8_SB(1, 0), b3, voffB);
            PG8_BAR; PG8_WAIT_L(0); PG8_MMA(0, 1, At, B1); PG8_BAR;
            PG8_LDA(At, 1, 1); PG8_STAGE(PG8_SA(1, 0), a3, voffA);
            PG8_BAR; PG8_WAIT_L(0); PG8_MMA(1, 0, At, B0); PG8_BAR; PG8_SCHED;
            PG8_STAGE(PG8_SB(1, 1), b3 + hstep, voffB);
            PG8_WAIT_V(6); PG8_BAR; PG8_MMA(1, 1, At, B1); PG8_BAR;
            }
        }
        if constexpr (ALIGN_EPI) { if (wr == 0) PG8_BAR; }
        if constexpr (!Epi::AFTER_DRAIN) { E(acc, cur, wr, wc, fr, fq); S.done(cur); }
        if (!has_next) break;
#pragma unroll
        for (int a = 0; a < 2; ++a)
#pragma unroll
            for (int b = 0; b < 2; ++b)
#pragma unroll
                for (int m = 0; m < 4; ++m)
#pragma unroll
                    for (int n = 0; n < 2; ++n) acc[a][b][m][n] = (f32x4){0.f, 0.f, 0.f, 0.f};
        cur = nxt; cA = nA; cB = nB; ++ui;
        if constexpr (ALIGN_EPI) { if (wr == 1) PG8_BAR; }
    }
    PG8_WAIT_V(0);
    if constexpr (!ALIGN_EPI) { if (wr == 0) PG8_BAR; }
    PG8_BAR;
    if constexpr (Epi::AFTER_DRAIN) { E.fused(acc, cur, wr, wc, fr, fq, lds, wid, lane); S.done(cur); }
#undef PG8_SA
#undef PG8_SB
#undef PG8_STAGE
#undef PG8_LDA
#undef PG8_LDB
#undef PG8_MMA
#undef PG8_WAIT_V
#undef PG8_WAIT_L
#undef PG8_BAR
#undef PG8_SCHED
}
}

#ifndef PG8_SP2
#define PG8_SP2 true
#endif
#ifndef PG8_ALIGN
#define PG8_ALIGN true
#endif
namespace att {
using bf16x8 = __attribute__((ext_vector_type(8))) short;
using s16x4  = __attribute__((ext_vector_type(4))) short;
using f32x16 = __attribute__((ext_vector_type(16))) float;
using u32x4  = __attribute__((ext_vector_type(4))) unsigned;
typedef unsigned short bf16r;
constexpr int LD = 2048, KVBLK = 64;
constexpr int SHM_V = 16384, SHM_K = 16384;
constexpr int SLOT = 32768, SLOT_K = 16384, OFF_WS = 3 * SLOT, OFF_TB = OFF_WS + 2048, OFF_STG_HI = OFF_TB + 8192, ATT_LDS = OFF_STG_HI + 32768;
__device__ __forceinline__ int stg_off(int w) { return w < 4 ? 2 * SLOT + w * 8192 : OFF_STG_HI + (w - 4) * 8192; }
constexpr float LOG2E = 1.4426950408889634f;
constexpr float THRL = 8.0f * 1.4426950408889634f;
#define KSWZ(row, colB) ((row) * 256 + ((colB) ^ (((row) & 7) << 4)))
#define SBAR() __builtin_amdgcn_sched_barrier(0)
__device__ __forceinline__ int crow(int r, int hi) { return (r & 3) + 8 * (r >> 2) + 4 * hi; }
__device__ __forceinline__ unsigned cvtpk(float lo, float hi) { unsigned r; asm volatile("v_cvt_pk_bf16_f32 %0, %1, %2" : "=v"(r) : "v"(lo), "v"(hi)); return r; }
__device__ __forceinline__ bf16x8 ld8(const bf16r* p) { return *reinterpret_cast<const bf16x8*>(p); }

__device__ __forceinline__ float rowmax32(const f32x16& p0, const f32x16& p1) {
  float pmax = p0[0];
#pragma unroll
  for (int r = 1; r < 16; ++r) pmax = fmaxf(pmax, p0[r]);
#pragma unroll
  for (int r = 0; r < 16; ++r) pmax = fmaxf(pmax, p1[r]);
  auto rr = __builtin_amdgcn_permlane32_swap(__float_as_uint(pmax), __float_as_uint(pmax), false, false);
  return fmaxf(__uint_as_float(rr[0]), __uint_as_float(rr[1]));
}
__device__ __forceinline__ void decide(float pmax, float& m_reg, float& mn, float& alpha) {
  const bool keep = __all(pmax - m_reg <= THRL);
  mn = keep ? m_reg : fmaxf(m_reg, pmax); alpha = keep ? 1.f : __builtin_amdgcn_exp2f(m_reg - mn); m_reg = mn;
}
__device__ __forceinline__ void scoreConst(f32x16& p0, f32x16& p1, float& m_reg, float& alpha) {
  const float pmax = rowmax32(p0, p1);
  alpha = 1.f;
  if (__builtin_expect(!__all(pmax <= THRL), 0)) { const float d = fmaxf(pmax, 0.f); m_reg += d; alpha = __builtin_amdgcn_exp2f(-d);
#pragma unroll
    for (int r = 0; r < 16; ++r) { p0[r] -= d; p1[r] -= d; } }
#pragma unroll
  for (int r = 0; r < 16; ++r) p0[r] = __builtin_amdgcn_exp2f(p0[r]);
}
__device__ __forceinline__ void scoreMid(f32x16& p0, f32x16& p1, float& m_reg, float& mn, float& alpha, int kq, const float* tb, int r32, int hi) {
  constexpr float C = 0.125f * LOG2E;
  const float* tp = tb + (kq + 256 - r32 + 4 * hi);
#pragma unroll
  for (int r = 0; r < 16; ++r) { const int e = (r & 3) + 8 * (r >> 2);
    p0[r] += tp[e]; p1[r] += tp[e + 32];
    if ((r & 3) == 3) asm volatile("" ::: "memory"); }
  const float pmax = rowmax32(p0, p1);
  decide(pmax, m_reg, mn, alpha);
#pragma unroll
  for (int r = 0; r < 16; ++r) { p0[r] -= mn; p1[r] -= mn; }
#pragma unroll
  for (int r = 0; r < 16; ++r) p0[r] = __builtin_amdgcn_exp2f(p0[r]);
}
__device__ __forceinline__ void scoreSM1(f32x16& p0, f32x16& p1, float& m_reg, float& mn, float& alpha, const float* rpr, const float (&pen0)[16], const float (&pen1)[16]) {
  constexpr float C = 0.08838834764831845f * LOG2E;
#pragma unroll
  for (int r = 0; r < 16; ++r) { const int e = (r & 3) + 8 * (r >> 2);
    p0[r] += rpr[e] + pen0[r]; p1[r] += rpr[e + 32] + pen1[r];
    if ((r & 3) == 3) asm volatile("" ::: "memory"); }
  const float pmax = rowmax32(p0, p1);
  decide(pmax, m_reg, mn, alpha);
#pragma unroll
  for (int r = 0; r < 16; ++r) { p0[r] -= mn; p1[r] -= mn; }
#pragma unroll
  for (int r = 0; r < 16; ++r) p0[r] = __builtin_amdgcn_exp2f(p0[r]);
}
__device__ __forceinline__ void finishSM(f32x16& p0, f32x16& p1, float alpha, float& l_reg, bf16x8& pa0, bf16x8& pa1, bf16x8& pa2, bf16x8& pa3) {
#pragma unroll
  for (int r = 0; r < 16; ++r) p1[r] = __builtin_amdgcn_exp2f(p1[r]);
  float ps = 0;
#pragma unroll
  for (int r = 0; r < 16; ++r) ps += p0[r];
#pragma unroll
  for (int r = 0; r < 16; ++r) ps += p1[r];
  { auto rr = __builtin_amdgcn_permlane32_swap(__float_as_uint(ps), __float_as_uint(ps), false, false);
    ps = __uint_as_float(rr[0]) + __uint_as_float(rr[1]); }
  l_reg = l_reg * alpha + ps;
#define PK4(P, BASE, OUT) do { unsigned a0 = cvtpk(P[BASE + 0], P[BASE + 1]), a1 = cvtpk(P[BASE + 2], P[BASE + 3]);   \
    unsigned b0 = cvtpk(P[BASE + 4], P[BASE + 5]), b1 = cvtpk(P[BASE + 6], P[BASE + 7]);                              \
    auto r0 = __builtin_amdgcn_permlane32_swap(a0, b0, false, false); auto r1 = __builtin_amdgcn_permlane32_swap(a1, b1, false, false); \
    u32x4 w = {r0[0], r1[0], r0[1], r1[1]}; OUT = *reinterpret_cast<bf16x8*>(&w); } while (0)
  PK4(p0, 0, pa0); PK4(p0, 8, pa1); PK4(p1, 0, pa2); PK4(p1, 8, pa3);
#undef PK4
}
template <int NQ> __device__ __forceinline__ void qkt(f32x16& p0, f32x16& p1, const char* Ks, const bf16x8* qr, int r32, int hi, int kcolB) {
  p0 = f32x16{}; p1 = f32x16{};
#pragma unroll
  for (int d0 = 0; d0 < NQ; ++d0) { const int cb = kcolB + (d0 * 16 + hi * 8) * 2;
    bf16x8 b0 = *reinterpret_cast<const bf16x8*>(Ks + KSWZ(r32, cb));
    bf16x8 b1 = *reinterpret_cast<const bf16x8*>(Ks + KSWZ(32 + r32, cb));
    p0 = __builtin_amdgcn_mfma_f32_32x32x16_bf16(b0, qr[d0], p0, 0, 0, 0);
    p1 = __builtin_amdgcn_mfma_f32_32x32x16_bf16(b1, qr[d0], p1, 0, 0, 0); }
}
__device__ __forceinline__ void qkt0(f32x16& p0, f32x16& p1, const char* Ks, const char* Qs, int r32, int hi, int kcolB, const f32x16& init) {
#pragma unroll
  for (int d0 = 0; d0 < 4; ++d0) { const int cb = kcolB + (d0 * 16 + hi * 8) * 2;
    bf16x8 b0 = *reinterpret_cast<const bf16x8*>(Ks + KSWZ(r32, cb));
    bf16x8 b1 = *reinterpret_cast<const bf16x8*>(Ks + KSWZ(32 + r32, cb));
    bf16x8 qf = *reinterpret_cast<const bf16x8*>(Qs + r32 * 128 + (((2 * d0 + hi) ^ (r32 & 7)) << 4));
    if (d0 == 0) { p0 = __builtin_amdgcn_mfma_f32_32x32x16_bf16(b0, qf, init, 0, 0, 0); p1 = __builtin_amdgcn_mfma_f32_32x32x16_bf16(b1, qf, init, 0, 0, 0); }
    else { p0 = __builtin_amdgcn_mfma_f32_32x32x16_bf16(b0, qf, p0, 0, 0, 0); p1 = __builtin_amdgcn_mfma_f32_32x32x16_bf16(b1, qf, p1, 0, 0, 0); } }
}
__device__ __forceinline__ void qkt_lq(f32x16& p0, f32x16& p1, const char* Ks, const char* Qs, int r32, int hi) {
  p0 = f32x16{}; p1 = f32x16{};
#pragma unroll
  for (int d0 = 0; d0 < 8; ++d0) { const int cb = (d0 * 16 + hi * 8) * 2;
    bf16x8 b0 = *reinterpret_cast<const bf16x8*>(Ks + KSWZ(r32, cb));
    bf16x8 b1 = *reinterpret_cast<const bf16x8*>(Ks + KSWZ(32 + r32, cb));
    bf16x8 qf = *reinterpret_cast<const bf16x8*>(Qs + KSWZ(r32, cb));
    p0 = __builtin_amdgcn_mfma_f32_32x32x16_bf16(b0, qf, p0, 0, 0, 0);
    p1 = __builtin_amdgcn_mfma_f32_32x32x16_bf16(b1, qf, p1, 0, 0, 0);
    if ((d0 & 1) == 1) SBAR(); }
}
__device__ __forceinline__ int v_st(int k, int c) { const int kk = (k & ~0xC) | ((k & 4) << 1) | ((k & 8) >> 1); return ((kk >> 3) * 4 + (c >> 5)) * 512 + ((kk & 7) * 32 + (c & 31)) * 2; }
__device__ __forceinline__ int v_rd_base(int lane) { return ((lane & 3) << 3) | (((lane >> 2) & 3) << 6) | (((lane >> 4) & 1) << 5) | (((lane >> 5) & 1) << 8); }
constexpr int v_rd_off(int d0, int ks, int half) { return d0 * 512 + ks * 4096 + half * 2048; }
template <int OFF> __device__ __forceinline__ s16x4 tr_read(int vb) {
  s16x4 r; asm volatile("ds_read_b64_tr_b16 %0, %1 offset:%2" : "=&v"(r) : "v"(vb), "i"(OFF) : "memory"); return r;
}
template <int D0> __device__ __forceinline__ void rd8(s16x4 (&l)[4], s16x4 (&h)[4], int vb) {
  l[0] = tr_read<v_rd_off(D0, 0, 0)>(vb); h[0] = tr_read<v_rd_off(D0, 0, 1)>(vb); l[1] = tr_read<v_rd_off(D0, 1, 0)>(vb); h[1] = tr_read<v_rd_off(D0, 1, 1)>(vb);
  l[2] = tr_read<v_rd_off(D0, 2, 0)>(vb); h[2] = tr_read<v_rd_off(D0, 2, 1)>(vb); l[3] = tr_read<v_rd_off(D0, 3, 0)>(vb); h[3] = tr_read<v_rd_off(D0, 3, 1)>(vb);
}
__device__ __forceinline__ void mma4(f32x16& od, const s16x4 (&l)[4], const s16x4 (&h)[4], bf16x8 pa0, bf16x8 pa1, bf16x8 pa2, bf16x8 pa3) {
#define PK(L, H) (bf16x8){L[0], L[1], L[2], L[3], H[0], H[1], H[2], H[3]}
  od = __builtin_amdgcn_mfma_f32_32x32x16_bf16(pa0, PK(l[0], h[0]), od, 0, 0, 0);
  od = __builtin_amdgcn_mfma_f32_32x32x16_bf16(pa1, PK(l[1], h[1]), od, 0, 0, 0);
  od = __builtin_amdgcn_mfma_f32_32x32x16_bf16(pa2, PK(l[2], h[2]), od, 0, 0, 0);
  od = __builtin_amdgcn_mfma_f32_32x32x16_bf16(pa3, PK(l[3], h[3]), od, 0, 0, 0);
#undef PK
}
#define WAITDEP(N, l, h) asm volatile("s_waitcnt lgkmcnt(" #N ")" : "+v"(l[0]), "+v"(l[1]), "+v"(l[2]), "+v"(l[3]), "+v"(h[0]), "+v"(h[1]), "+v"(h[2]), "+v"(h[3]) :: "memory")
__device__ __forceinline__ void pv_d0(f32x16* o, int vb, bf16x8 pa0, bf16x8 pa1, bf16x8 pa2, bf16x8 pa3) {
  s16x4 la[4], ha[4];
  rd8<0>(la, ha, vb); WAITDEP(0, la, ha); mma4(o[0], la, ha, pa0, pa1, pa2, pa3);
  rd8<1>(la, ha, vb); WAITDEP(0, la, ha); mma4(o[1], la, ha, pa0, pa1, pa2, pa3);
  rd8<2>(la, ha, vb); WAITDEP(0, la, ha); mma4(o[2], la, ha, pa0, pa1, pa2, pa3);
  rd8<3>(la, ha, vb); WAITDEP(0, la, ha); mma4(o[3], la, ha, pa0, pa1, pa2, pa3);
}
#undef WAITDEP

template <int MODE>
__device__ __forceinline__ void attn_unit(bf16r* P0, const bf16r* __restrict__ PKV, int rowbase, int seqL, int h, int blk, float lam,
                                          const float* __restrict__ subg, const float* __restrict__ tsrc, char* lds) {
  constexpr int NQ = (MODE == 0) ? 4 : 8;
  int tid_ = threadIdx.x; asm volatile("" : "+v"(tid_));
  const int tid = tid_, wid = __builtin_amdgcn_readfirstlane(tid >> 6), lane = tid & 63, r32 = lane & 31, hi = lane >> 5;
  float* ws = (float*)(lds + OFF_WS) + wid * 64; float* li_l = ws; float* al_l = ws + 32;
  float* tb = (float*)(lds + OFF_TB);
  int qrow, kcolB, tbase, NT, colbase, gr = 0, rs = 0, qc = 0, cmap = 0;
  float bL = 0.f, bR = 0.f;
  if constexpr (MODE == 0) {
    cmap = wid >> 2; qrow = blk * 128 + (wid & 3) * 32; kcolB = cmap * 128; tbase = 0; NT = seqL / KVBLK; colbase = h * 128;
    bL = tsrc[15 * 8 + h] * LOG2E; bR = tsrc[31 * 8 + h] * LOG2E;
    { const int rel = tid - 256, n = rel < 0 ? -rel : rel;
      int bk = n < 8 ? n : min(15, 8 + (31 - __clz((n * n) >> 6))); if (rel > 0) bk += 16;
      tb[tid] = tsrc[bk * 8 + h] * LOG2E; }
  } else {
    const int rows = seqL / 64; qrow = blk * 256 + wid * 32; kcolB = 0; colbase = 1024 + h * 128; NT = 12;
    const int rs0 = min(max(blk * 4 - 4, 0), rows - 8); tbase = min(rs0, rows - 12);
    gr = blk * 4 + (wid >> 1); rs = min(max(gr - 4, 0), rows - 8); qc = (wid & 1) * 32 + r32;
    for (int i = tid; i < 15 * 128; i += 512) { const int dr = i >> 7, dc = (i & 127) - 48; tb[i] = (dc >= 0 && dc < 31) ? tsrc[(h * 15 + dr) * 31 + dc] * LOG2E : 0.f; }
  }
  const bf16r* Qw = P0 + (size_t)(rowbase + qrow + r32) * LD + colbase + (MODE == 0 ? cmap * 64 : 0) + hi * 8;
  const bf16r* Kh = PKV + (size_t)rowbase * LD + h * 128; const bf16r* Vh = Kh + 1024;
  float m_reg = -1e30f, l_reg = 0; f32x16 o[4] = {};
  char* Qs = (MODE == 0) ? lds + OFF_STG_HI + wid * 4096 : lds + stg_off(wid);
  if constexpr (MODE == 0) {
#pragma unroll
    for (int d0 = 0; d0 < 4; ++d0) { const bf16x8 qv = ld8(Qw + d0 * 16); *(bf16x8*)(Qs + r32 * 128 + (((2 * d0 + hi) ^ (r32 & 7)) << 4)) = qv; }
  } else {
#pragma unroll
    for (int d0 = 0; d0 < 8; ++d0) { const bf16x8 qv = ld8(Qw + d0 * 16); *(bf16x8*)(Qs + KSWZ(r32, (d0 * 16 + hi * 8) * 2)) = qv; }
  }
  const int sr = tid >> 4, sc = (tid & 15) * 8, vst0 = v_st(sr, sc), vst1 = v_st(32 + sr, sc);
  const int vb0 = (int)(uintptr_t)lds + v_rd_base(lane);
  struct { bf16x8 vs0, vs1, ks0, ks1; } sr_[1];
#define KOFF(t) ((tbase + (t)) * KVBLK)
#define SLOAD(i, k0) do { sr_[i].vs0 = ld8(&Vh[(size_t)((k0) + sr) * LD + sc]); sr_[i].vs1 = ld8(&Vh[(size_t)((k0) + 32 + sr) * LD + sc]); \
    sr_[i].ks0 = ld8(&Kh[(size_t)((k0) + sr) * LD + sc]); sr_[i].ks1 = ld8(&Kh[(size_t)((k0) + 32 + sr) * LD + sc]); } while (0)
#define SWRITE(soff, i) do { char* sb_ = lds + (soff); *(bf16x8*)(sb_ + vst0) = sr_[i].vs0;          \
    *(bf16x8*)(sb_ + vst1) = sr_[i].vs1; int kc_ = sc * 2;               \
    *(bf16x8*)(sb_ + SLOT_K + KSWZ(sr, kc_)) = sr_[i].ks0;                       \
    *(bf16x8*)(sb_ + SLOT_K + KSWZ(32 + sr, kc_)) = sr_[i].ks1; } while (0)
#define SWAIT() asm volatile("s_waitcnt vmcnt(0)" ::: "memory")
#define RESC(a) do { if (__any((a) < 1.f)) { if (hi == 0) al_l[r32] = (a); asm volatile("s_waitcnt lgkmcnt(0)" ::: "memory"); \
    _Pragma("unroll") for (int d = 0; d < 4; ++d) _Pragma("unroll") for (int r = 0; r < 16; ++r) o[d][r] *= al_l[crow(r, hi)]; } } while (0)
  bf16x8 pa0, pa1, pa2, pa3;
  if constexpr (MODE == 0) {
    const int tm0 = max(2 * blk - 2, 0), tm1 = min(2 * blk + 4, NT), nmid = tm1 - tm0, NH = NT - nmid;
    {
      f32x16 pM0, pM1; float mnM, alM; f32x16 zinit = {};
      SLOAD(0, KOFF(tm0)); asm volatile("s_waitcnt vmcnt(0)" ::: "memory"); SWRITE(0, 0); __syncthreads();
#pragma nounroll
      for (int t = 0; t < nmid; ++t) {
        const int so = (t & 1) * SLOT;
        if (t + 1 < nmid) SLOAD(0, KOFF(tm0 + t + 1));
        SBAR(); qkt0(pM0, pM1, lds + so + SLOT_K, Qs, r32, hi, kcolB, zinit);
        scoreMid(pM0, pM1, m_reg, mnM, alM, KOFF(tm0 + t) - qrow, tb, r32, hi); RESC(alM);
        finishSM(pM0, pM1, alM, l_reg, pa0, pa1, pa2, pa3); SBAR();
        pv_d0(o, vb0 + so, pa0, pa1, pa2, pa3); SBAR();
        if (t + 1 < nmid) { SWAIT(); SWRITE(SLOT - so, 0); }
        __syncthreads();
      }
    }
    f32x16 pA0, pA1, pB0, pB1; float mnA, mnB, alA, alB;
#define HT(i) ((i) < tm0 ? (i) : (i) + nmid)
#define CB(i) ((i) < tm0 ? bL : bR)
    SLOAD(0, KOFF(HT(0))); asm volatile("s_waitcnt vmcnt(0)" ::: "memory"); SWRITE(0, 0);
    SLOAD(0, KOFF(HT(1))); asm volatile("s_waitcnt vmcnt(0)" ::: "memory"); SWRITE(SLOT, 0);
    SLOAD(0, KOFF(HT(2)));
    __syncthreads();
    f32x16 negm;
#define NEGM(i) do { const float nv_ = CB(i) - m_reg; if (__any(nv_ != negm[0])) { _Pragma("unroll") for (int r = 0; r < 16; ++r) negm[r] = nv_; asm volatile("" : "+v"(negm)); } } while (0)
    { const float nv_ = CB(0) - m_reg; _Pragma("unroll") for (int r = 0; r < 16; ++r) negm[r] = nv_; asm volatile("" : "+v"(negm)); }
    qkt0(pA0, pA1, lds + SLOT_K, Qs, r32, hi, kcolB, negm); scoreConst(pA0, pA1, m_reg, alA);
    int sPrev = 0, sCur = SLOT, sNext = 2 * SLOT;
#define ROT() do { const int t_ = sPrev; sPrev = sCur; sCur = sNext; sNext = t_; } while (0)
#define STEP(PX0, PX1, MNX, ALX, PY0, PY1, ALY, i) do { \
      NEGM(i); SBAR(); qkt0(PX0, PX1, lds + sCur + SLOT_K, Qs, r32, hi, kcolB, negm); \
      finishSM(PY0, PY1, ALY, l_reg, pa0, pa1, pa2, pa3); SBAR(); \
      pv_d0(o, vb0 + sPrev, pa0, pa1, pa2, pa3); \
      SWAIT(); SWRITE(sNext, 0); { const int tn_ = min((i) + 2, NH - 1); SLOAD(0, KOFF(HT(tn_))); } \
      scoreConst(PX0, PX1, m_reg, ALX); SBAR(); \
      RESC(ALX); ROT(); __syncthreads(); } while (0)
    for (int j = 1; j + 1 < NH; j += 2) {
      STEP(pB0, pB1, mnB, alB, pA0, pA1, alA, j);
      STEP(pA0, pA1, mnA, alA, pB0, pB1, alB, j + 1);
    }
    NEGM(NH - 1); SBAR(); qkt0(pB0, pB1, lds + sCur + SLOT_K, Qs, r32, hi, kcolB, negm);
    finishSM(pA0, pA1, alA, l_reg, pa0, pa1, pa2, pa3); SBAR();
    pv_d0(o, vb0 + sPrev, pa0, pa1, pa2, pa3); scoreConst(pB0, pB1, m_reg, alB); SBAR();
    RESC(alB);
    finishSM(pB0, pB1, alB, l_reg, pa0, pa1, pa2, pa3); SBAR();
    pv_d0(o, vb0 + sCur, pa0, pa1, pa2, pa3);
#undef ROT
#undef STEP
#undef NEGM
#undef HT
#undef CB
  } else {
    f32x16 pA0, pA1; float mnA, alA;
    float pen0[16], pen1[16];
    { const int cs = min(max(qc - 8, 0), 48);
#pragma unroll
      for (int r = 0; r < 16; ++r) { const int kc = (r & 3) + 8 * (r >> 2) + 4 * hi;
        pen0[r] = ((unsigned)(kc - cs) < 16u) ? 0.f : -1e30f; pen1[r] = ((unsigned)(kc + 32 - cs) < 16u) ? 0.f : -1e30f; } }
    const float* rpl = tb + (4 * hi - qc + 63);
    SLOAD(0, KOFF(0)); asm volatile("s_waitcnt vmcnt(0)" ::: "memory"); SWRITE(0, 0); __syncthreads();
#pragma nounroll
    for (int t = 0; t < NT; ++t) {
      const int b = t & 1;
      if (t + 1 < NT) SLOAD(0, KOFF(t + 1));
      if ((unsigned)(tbase + t - rs) < 8u) {
        int ln_ = lane; asm volatile("" : "+v"(ln_)); const int r32v = ln_ & 31, hiv = ln_ >> 5;
        SBAR(); qkt_lq(pA0, pA1, lds + b * SLOT + SLOT_K, Qs, r32v, hiv);
        scoreSM1(pA0, pA1, m_reg, mnA, alA, rpl + (tbase + t - gr + 7) * 128, pen0, pen1); RESC(alA);
        finishSM(pA0, pA1, alA, l_reg, pa0, pa1, pa2, pa3); SBAR();
        pv_d0(o, vb0 + b * SLOT, pa0, pa1, pa2, pa3); SBAR();
      }
      if (t + 1 < NT) { SWAIT(); SWRITE(SLOT - b * SLOT, 0); }
      __syncthreads();
    }
  }
  if (hi == 0) li_l[r32] = l_reg; asm volatile("s_waitcnt lgkmcnt(0)" ::: "memory");
  float rli[16];
#pragma unroll
  for (int r = 0; r < 16; ++r) rli[r] = __builtin_amdgcn_rcpf(li_l[crow(r, hi)]);
  bf16r* stg = (bf16r*)(lds + stg_off(wid));
  bf16r* Ow = P0 + (size_t)(rowbase + qrow) * LD + colbase;
  __syncthreads();
  if constexpr (MODE == 0) {
    float* X = (float*)lds + (wid & 3) * 4096;
    if (cmap == 1) {
#pragma unroll
      for (int d0 = 0; d0 < 4; ++d0)
#pragma unroll
        for (int r = 0; r < 16; ++r) X[(d0 * 16 + r) * 64 + lane] = o[d0][r] * rli[r] * lam;
    }
    __syncthreads();
    if (cmap == 0) {
#pragma unroll
      for (int d0 = 0; d0 < 4; ++d0)
#pragma unroll
        for (int r = 0; r < 16; ++r) o[d0][r] = o[d0][r] * rli[r] - X[(d0 * 16 + r) * 64 + lane];
      float gc[4];
#pragma unroll
      for (int d0 = 0; d0 < 4; ++d0) gc[d0] = subg[d0 * 32 + r32] * 0.8f;
#pragma unroll
      for (int r = 0; r < 16; ++r) { float ss = (o[0][r] * o[0][r] + o[1][r] * o[1][r]) + (o[2][r] * o[2][r] + o[3][r] * o[3][r]);
        ss += __shfl_xor(ss, 1); ss += __shfl_xor(ss, 2); ss += __shfl_xor(ss, 4); ss += __shfl_xor(ss, 8); ss += __shfl_xor(ss, 16);
        const float rinv = __builtin_amdgcn_rsqf(ss * (1.0f / 128.0f) + 1e-6f); const int orow = crow(r, hi);
#pragma unroll
        for (int d0 = 0; d0 < 4; ++d0) stg[orow * 128 + d0 * 32 + r32] = (bf16r)(cvtpk(o[d0][r] * rinv * gc[d0], 0.f) & 0xffffu); }
      asm volatile("s_waitcnt lgkmcnt(0)" ::: "memory");
#pragma unroll
      for (int i = 0; i < 8; ++i) { const int row = i * 4 + (lane >> 4), ch = lane & 15; const u32x4 v = *(const u32x4*)(stg + row * 128 + ch * 8); *(u32x4*)(Ow + (size_t)row * LD + ch * 8) = v; }
    }
  } else {
#pragma unroll
    for (int r = 0; r < 16; ++r) { const int orow = crow(r, hi);
#pragma unroll
      for (int d0 = 0; d0 < 4; ++d0) stg[orow * 128 + d0 * 32 + r32] = (bf16r)(cvtpk(o[d0][r] * rli[r], 0.f) & 0xffffu); }
    asm volatile("s_waitcnt lgkmcnt(0)" ::: "memory");
#pragma unroll
    for (int i = 0; i < 8; ++i) { const int row = i * 4 + (lane >> 4), ch = lane & 15; const u32x4 v = *(const u32x4*)(stg + row * 128 + ch * 8); *(u32x4*)(Ow + (size_t)row * LD + ch * 8) = v; }
  }
  __syncthreads();
#undef KOFF
#undef SLOAD
#undef SWRITE
#undef SWAIT
#undef RESC
}
#undef SBAR
}

namespace cg = cooperative_groups;
#define LAS __attribute__((address_space(3)))
typedef unsigned short bf16;
typedef unsigned v4u __attribute__((ext_vector_type(4)));
typedef float f32x4 __attribute__((ext_vector_type(4)));
constexpr int NWAVES = 8;
constexpr int MTOK = 32768, MP = 16384, DMODEL = 2048, NIN = 6144, DFF = 5504, NUP = 11008;
constexpr float EPS = 1e-6f;
constexpr size_t MiB = 1u << 20;
constexpr size_t WS_BAR = 512 * 1024, WS_BAR_BYTES = 16384;
constexpr size_t WS_SS2 = 0, WS_SS3 = 1 * MiB, WS_WIN = 5 * MiB, WS_WOUT = 29 * MiB, WS_WUP = 37 * MiB, WS_WDN = 80 * MiB;
constexpr size_t WS_P0 = 102 * MiB, WS_P1 = 230 * MiB, WS_P2 = 358 * MiB, WS_END = 486 * MiB;
constexpr size_t WS_U = WS_P0, WS_EP = WS_P0 + 172 * MiB, WS_EA = WS_EP + 11 * MiB, WS_EG = WS_EA + 11 * MiB;
static_assert((size_t)MP * DFF * 2 <= 172 * MiB && (size_t)512 * DFF * 4 <= 11 * MiB && WS_EG + 11 * MiB <= WS_P2, "FFN overlay");
constexpr int LDS_BYTES = 147456;
static_assert(att::ATT_LDS <= LDS_BYTES - 16 && pg8::STAGE_BYTES <= LDS_BYTES - 16, "LDS map");

__device__ __forceinline__ unsigned cvt_pk(float lo, float hi) { unsigned r; asm volatile("v_cvt_pk_bf16_f32 %0, %1, %2" : "=v"(r) : "v"(lo), "v"(hi)); return r; }
__device__ __forceinline__ float wave_sum(float v) {
#pragma unroll
    for (int o = 1; o < 64; o <<= 1) v += __shfl_xor(v, o);
    return v;
}
struct TItem { const float* src; bf16* dst; const float* g; int N, K; };
__device__ __forceinline__ void item_load(const TItem& t, float (&v)[32], int lane) {
#pragma unroll
    for (int i = 0; i < 32; ++i) v[i] = t.src[(size_t)(2 * i + (lane >> 5)) * t.N + (lane & 31)];
}
__device__ __forceinline__ void item_store(const TItem& t, const float (&v)[32], LAS float* scr, int lane) {
#pragma unroll
    for (int i = 0; i < 32; ++i) scr[(2 * i + (lane >> 5)) * 33 + (lane & 31)] = v[i];
    asm volatile("s_waitcnt lgkmcnt(0)" ::: "memory");
    const int c = lane & 7;
    f32x4 g0 = {1.f, 1.f, 1.f, 1.f}, g1 = g0;
    if (t.g) { g0 = *(const f32x4*)(t.g + 8 * c); g1 = *(const f32x4*)(t.g + 8 * c + 4); }
#pragma unroll
    for (int j = 0; j < 4; ++j) { const int n = (lane >> 3) + 8 * j; const LAS float* sp = scr + (8 * c) * 33 + n;
        v4u o; o.x = cvt_pk(sp[0 * 33] * g0[0], sp[1 * 33] * g0[1]); o.y = cvt_pk(sp[2 * 33] * g0[2], sp[3 * 33] * g0[3]);
        o.z = cvt_pk(sp[4 * 33] * g1[0], sp[5 * 33] * g1[1]); o.w = cvt_pk(sp[6 * 33] * g1[2], sp[7 * 33] * g1[3]);
        *(v4u*)(t.dst + (size_t)n * t.K + 8 * c) = o; }
    asm volatile("s_waitcnt lgkmcnt(0)" ::: "memory");
}

#define XB_TMO      128
#define XB_XCNT(j)  (256  + 64 * (j))
#define XB_XSUB(j)  (1280 + 64 * (j))
#define XB_XGEN(j)  (2304 + 64 * (j))
#define XB_TOP      3328
#define XB_TOPGEN   3392
#define XCD_BAR_WORDS 3456
#define XB_SPIN_CAP (1u << 22)

__device__ __forceinline__ unsigned xb_ld(unsigned* p)              { return __hip_atomic_load(p, __ATOMIC_RELAXED, __HIP_MEMORY_SCOPE_AGENT); }
__device__ __forceinline__ unsigned xb_add(unsigned* p, unsigned v) { return __hip_atomic_fetch_add(p, v, __ATOMIC_RELAXED, __HIP_MEMORY_SCOPE_AGENT); }
__device__ __forceinline__ unsigned xb_xcc_id() { return (unsigned)__builtin_amdgcn_s_getreg((3 << 11) | 20) & 0xFu; }
#define XB_SPIN(cond, bar) do { unsigned _sp = 0; while (cond) { __builtin_amdgcn_s_sleep(1); \
    if ((++_sp & 255u) == 0u) { if (xb_ld(&(bar)[XB_TMO])) break; if (_sp > XB_SPIN_CAP) { atomicAdd(&(bar)[XB_TMO], 1u); break; } } } } while (0)

struct XcdBarrier {
    unsigned* bar; unsigned x;
    volatile LAS unsigned* st;
};

__device__ __forceinline__ XcdBarrier xcd_barrier_post(unsigned* bar, volatile LAS unsigned* st) {
    XcdBarrier b; b.bar = bar; b.x = xb_xcc_id(); b.st = st;
    if (threadIdx.x == 0) (void)xb_add(&bar[XB_XCNT(b.x)], 1u);
    return b;
}
__device__ __forceinline__ void xcd_barrier_complete(unsigned* bar, unsigned x, unsigned& nloc, unsigned& nx) {
    const unsigned G = gridDim.x * gridDim.y * gridDim.z;
    unsigned sum, cnt, mine, sp = 0u;
    for (;;) {
        sum = 0u; cnt = 0u; mine = 0u;
#pragma unroll
        for (unsigned j = 0; j < 16; ++j) { const unsigned c = xb_ld(&bar[XB_XCNT(j)]); sum += c; cnt += (c > 0u) ? 1u : 0u; mine = (j == x) ? c : mine; }
        if (sum == G) break;
        __builtin_amdgcn_s_sleep(1);
        if ((++sp & 255u) == 0u) { if (xb_ld(&bar[XB_TMO])) break; if (sp > XB_SPIN_CAP) { atomicAdd(&bar[XB_TMO], 1u); break; } }
    }
    nloc = mine > 0u ? mine : 1u; nx = cnt > 0u ? cnt : 1u;
}

__device__ __forceinline__ void xcd_barrier(const XcdBarrier& b) {
    asm volatile("s_waitcnt vmcnt(0)" ::: "memory");
    __syncthreads();
    if (threadIdx.x == 0) {
        unsigned* bar = b.bar;
        __builtin_amdgcn_s_waitcnt(0);
        unsigned nloc = b.st[0], nx = b.st[1];
        if (nloc == 0u) { xcd_barrier_complete(bar, b.x, nloc, nx); b.st[0] = nloc; b.st[1] = nx; }
        const unsigned old = xb_add(&bar[XB_XSUB(b.x)], 1u);
        const unsigned gen = old / nloc;
        if (old + 1u == (gen + 1u) * nloc) {
            __builtin_amdgcn_fence(__ATOMIC_RELEASE, "agent");
            asm volatile("s_waitcnt vmcnt(0)" ::: "memory");
            const unsigned og = xb_add(&bar[XB_TOP], 1u);
            const unsigned tg = og / nx;
            if (og + 1u == (tg + 1u) * nx) xb_add(&bar[XB_TOPGEN], 1u);
            else XB_SPIN(xb_ld(&bar[XB_TOPGEN]) == tg, bar);
            __builtin_amdgcn_fence(__ATOMIC_ACQUIRE, "agent");
            xb_add(&bar[XB_XGEN(b.x)], 1u);
            asm volatile("s_waitcnt vmcnt(0)" ::: "memory");
        } else {
            XB_SPIN(xb_ld(&bar[XB_XGEN(b.x)]) == gen, bar);
            __builtin_amdgcn_fence(__ATOMIC_ACQUIRE, "agent");
            asm volatile("s_waitcnt vmcnt(0)" ::: "memory");
        }
    }
    __syncthreads();
}

struct Args {
    const float* x_prompt; const float* x_sample; const float* w_in; const float* w_out; const float* norm1_g; const float* norm2_g; const float* final_g;
    const float* lq1; const float* lk1; const float* lq2; const float* lk2; const float* subln_g; const float* rel_tab; const float* na_rpb;
    const float* w_up; const float* conv_w; const float* conv_b; const float* w_down;
    float* out; unsigned char* ws;
};

__global__ void __launch_bounds__(NWAVES * 64, 2) mk_fwd(Args a_unused) {
    extern __shared__ __attribute__((aligned(16))) unsigned char lds[];
    cg::grid_group grid = cg::this_grid();
    const int tid = threadIdx.x, lane = tid & 63, wave = __builtin_amdgcn_readfirstlane(tid >> 6);
    const int G = gridDim.x, bx = blockIdx.x;
    const int vcu = (G % 8 == 0) ? (bx % 8) * (G / 8) + bx / 8 : bx;
#define LOADARGS() const __attribute__((address_space(4))) Args* ap_ = (const __attribute__((address_space(4))) Args*)__builtin_amdgcn_kernarg_segment_ptr(); asm volatile("" : "+s"(ap_)); \
    const __attribute__((address_space(4))) Args& a = *ap_; unsigned char* const ws = a.ws; (void)ws
#define SS2 ((float*)(ws + WS_SS2))
#define SS3 ((float*)(ws + WS_SS3))
#define Win_t ((bf16*)(ws + WS_WIN))
#define Wout_t ((bf16*)(ws + WS_WOUT))
#define Wup_t ((bf16*)(ws + WS_WUP))
#define Wdn_t ((bf16*)(ws + WS_WDN))
#define P0 ((bf16*)(ws + WS_P0))
#define P1 ((bf16*)(ws + WS_P1))
#define P2 ((bf16*)(ws + WS_P2))
#define XN1 ((bf16*)a.out)
#define XN2 P2
#define U ((bf16*)(ws + WS_U))
#define EP ((float*)(ws + WS_EP))
#define EA ((float*)(ws + WS_EA))
#define EG ((float*)(ws + WS_EG))
    LAS unsigned char* ldsl = (LAS unsigned char*)lds;
    volatile LAS unsigned* bst = (volatile LAS unsigned*)(ldsl + LDS_BYTES - 16);
    if (tid < 2) bst[tid] = 0u;
    __syncthreads();
#define GSYNC() do { LOADARGS(); XcdBarrier b_; b_.bar = (unsigned*)(ws + WS_BAR); b_.x = xb_xcc_id(); b_.st = (volatile LAS unsigned*)(ldsl + LDS_BYTES - 16); xcd_barrier(b_); } while (0)
    const int gw = vcu * NWAVES + wave, NGW = G * NWAVES;

#ifndef PHMASK
#define PHMASK 0xFF
#endif
    if (PHMASK & 1) { LOADARGS();
        LAS float* scr = (LAS float*)(ldsl + wave * 16384);
        constexpr int I_IN = (DMODEL / 64) * (NIN / 32), I_OUT = (DMODEL / 64) * (DMODEL / 32), I_UP = (DMODEL / 64) * (NUP / 32), I_DN = (DFF / 64) * (DMODEL / 32);
        constexpr int NITEMS = I_IN + I_OUT + I_UP + I_DN;
#define DECODE(T, it_) do { int r = (it_); \
            if (r < I_IN) { const int nblk = NIN / 32, kb = r / nblk, nb = r % nblk, n0 = nb * 32, blk = n0 >> 10; \
                  \
                const int oblk = (blk == 0) ? 0 : (blk == 1) ? 2 : (blk == 2) ? 3 : (blk == 3) ? 1 : blk; \
                T.src = a.w_in + (size_t)(kb * 64) * NIN + n0; T.dst = Win_t + (size_t)(oblk * 1024 + (n0 & 1023)) * DMODEL + kb * 64; T.g = a.norm1_g + kb * 64; T.N = NIN; T.K = DMODEL; } \
            else if ((r -= I_IN) < I_OUT) { const int nblk = DMODEL / 32, kb = r / nblk, nb = r % nblk; \
                T.src = a.w_out + (size_t)(kb * 64) * DMODEL + nb * 32; T.dst = Wout_t + (size_t)(nb * 32) * DMODEL + kb * 64; T.g = nullptr; T.N = DMODEL; T.K = DMODEL; } \
            else if ((r -= I_OUT) < I_UP) { const int nblk = NUP / 32, kb = r / nblk, nb = r % nblk, n0 = nb * 32; const int isg = n0 >= DFF ? 1 : 0, j = n0 - isg * DFF; \
                T.src = a.w_up + (size_t)(kb * 64) * NUP + n0; T.dst = Wup_t + (size_t)((j >> 7) * 256 + isg * 128 + (j & 127)) * DMODEL + kb * 64; T.g = a.norm2_g + kb * 64; T.N = NUP; T.K = DMODEL; } \
            else { r -= I_UP; const int nblk = DMODEL / 32, kb = r / nblk, nb = r % nblk; \
                T.src = a.w_down + (size_t)(kb * 64) * DMODEL + nb * 32; T.dst = Wdn_t + (size_t)(nb * 32) * DFF + kb * 64; T.g = nullptr; T.N = DMODEL; T.K = DFF; } } while (0)
        {
            TItem t0, t1; float va[32], vb[32];
            int it = gw;
            if (it < NITEMS) { DECODE(t0, it); item_load(t0, va, lane); }
            for (; it < NITEMS; it += NGW) {
                const int nit = it + NGW; const bool more = nit < NITEMS;
                if (more) { DECODE(t1, nit); item_load(t1, vb, lane); }
                item_store(t0, va, scr, lane);
                if (more) { t0 = t1;
#pragma unroll
                    for (int i = 0; i < 32; ++i) va[i] = vb[i]; }
            }
        }
#undef DECODE
        {
            f32x4 v[8], w[8];
            int m = gw;
#define ROWPTR(m_) ((const f32x4*)(((m_) < MP) ? a.x_prompt + (size_t)(m_) * DMODEL : a.x_sample + (size_t)((m_) - MP) * DMODEL) + lane)
            if (m < MTOK) { const f32x4* xr = ROWPTR(m);
#pragma unroll
                for (int j = 0; j < 8; ++j) v[j] = xr[64 * j]; }
            for (; m < MTOK; m += NGW) {
                const int nm = m + NGW; const bool more = nm < MTOK;
                if (more) { const f32x4* xr = ROWPTR(nm);
#pragma unroll
                    for (int j = 0; j < 8; ++j) w[j] = xr[64 * j]; }
                float sq = 0.f;
#pragma unroll
                for (int j = 0; j < 8; ++j) sq += (v[j].x * v[j].x + v[j].y * v[j].y) + (v[j].z * v[j].z + v[j].w * v[j].w);
                const float rstd = 1.0f / sqrtf(wave_sum(sq) * (1.0f / DMODEL) + EPS);
                unsigned long long* o8 = (unsigned long long*)(XN1 + (size_t)m * DMODEL) + lane;
#pragma unroll
                for (int j = 0; j < 8; ++j) o8[64 * j] = (unsigned long long)cvt_pk(v[j].x * rstd, v[j].y * rstd) | ((unsigned long long)cvt_pk(v[j].z * rstd, v[j].w * rstd) << 32);
                if (more) {
#pragma unroll
                    for (int j = 0; j < 8; ++j) v[j] = w[j]; }
            }
#undef ROWPTR
        }
        for (int i = bx * (NWAVES * 64) + tid; i < MTOK; i += G * NWAVES * 64) SS2[i] = 0.f;
        if (bx == 0) for (int i = tid; i < XCD_BAR_WORDS; i += NWAVES * 64) ((unsigned*)(ws + WS_BAR))[i] = 0u;
    }
    grid.sync();
    { LOADARGS(); (void)xcd_barrier_post((unsigned*)(ws + WS_BAR), bst); }

    if (PHMASK & 2) { LOADARGS();
        pg8::Gemm g{XN1, Win_t, MTOK, NIN, DMODEL}; pg8::StaticOrder S; S.init(MTOK, NIN, G, bx);
        pg8::EpiBf16<0> E{P0, DMODEL, nullptr, DMODEL, (size_t)(WS_P1 - WS_P0) / 2, 0.125f * att::LOG2E, 0.08838834764831845f * att::LOG2E};
        pg8::gemm_phase<pg8::EpiBf16<0>, pg8::StaticOrder, PG8_ALIGN, PG8_SP2>(ldsl, g, S, E);
    }
    GSYNC();

    if (PHMASK & 4) { LOADARGS();
        float s1 = wave_sum(a.lq1[lane] * a.lk1[lane]), s2 = wave_sum(a.lq2[lane] * a.lk2[lane]);
        const float lam = expf(s1) - expf(s2) + 0.2f;
        for (int u = vcu; u < 3072; u += G) {
#ifndef ATTM
#define ATTM 3
#endif
            if (u < 2048) { if (ATTM & 1) {
                int rowbase, seqL, bh, qb;
                if (u < 1024) { bh = u >> 6; qb = u & 63; rowbase = (bh >> 3) * 8192; seqL = 8192; }
                else { const int v = u - 1024; bh = v >> 5; qb = v & 31; rowbase = MP + (bh >> 3) * 4096; seqL = 4096; }
                att::attn_unit<0>(P0, P1, rowbase, seqL, bh & 7, qb, lam, a.subln_g, a.rel_tab, (char*)lds); }
            } else if (ATTM & 2) {
                int rowbase, seqL, bh, rb;
                if (u < 2560) { const int v = u - 2048; bh = v >> 5; rb = v & 31; rowbase = (bh >> 3) * 8192; seqL = 8192; }
                else { const int v = u - 2560; bh = v >> 4; rb = v & 15; rowbase = MP + (bh >> 3) * 4096; seqL = 4096; }
                att::attn_unit<1>(P0, P2, rowbase, seqL, bh & 7, rb, lam, a.subln_g, a.na_rpb, (char*)lds);
            }
        }
    }
    GSYNC();

    if (PHMASK & 8) { LOADARGS();
        pg8::Gemm g{P0, Wout_t, MTOK, DMODEL, DMODEL}; pg8::StaticOrder S; S.init(MTOK, DMODEL, G, bx);
        pg8::EpiOut E{a.x_prompt, a.x_sample, a.out, XN2, SS2};
        pg8::gemm_phase<pg8::EpiOut, pg8::StaticOrder, PG8_ALIGN, PG8_SP2>(ldsl, g, S, E);
    }
    GSYNC();

#pragma unroll
    for (int ch = 0; ch < 2; ++ch) {
        const size_t r0 = (size_t)ch * MP; const int Lseq = ch == 0 ? 8192 : 4096;
        if (PHMASK & 16) { LOADARGS();
            pg8::Gemm g{XN2 + r0 * DMODEL, Wup_t, MP, NUP, DMODEL}; pg8::StaticOrder S; S.init(MP, NUP, G, bx);
            pg8::EpiUp E{U, SS2 + r0, a.conv_w, a.conv_b, EP, EA, EG};
            pg8::gemm_phase<pg8::EpiUp, pg8::StaticOrder, PG8_ALIGN, PG8_SP2>(ldsl, g, S, E);
        }
        GSYNC();
        if (PHMASK & 32) { LOADARGS();
            constexpr int CPR = DFF / 8;
            for (int it = bx * (NWAVES * 64) + tid; it < 512 * CPR; it += G * NWAVES * 64) {
                const int e = it / CPR, j0 = (it % CPR) * 8, side = e & 1, row = (e >> 1) * 64 + (side ? 63 : 0);
                const bool has_nb = side ? (((row + 1) % Lseq) != 0) : ((row % Lseq) != 0);
                const int nb = side ? e + 1 : e - 1;
                const float* wv = a.conv_w + (side ? 2 * DFF : 0) + j0;
                float c[8], gg[8];
#pragma unroll
                for (int k = 0; k < 2; ++k) { const f32x4 p = *(const f32x4*)(EP + (size_t)e * DFF + j0 + 4 * k), g4 = *(const f32x4*)(EG + (size_t)e * DFF + j0 + 4 * k);
                    f32x4 t = p; if (has_nb) { const f32x4 an = *(const f32x4*)(EA + (size_t)nb * DFF + j0 + 4 * k), w4 = *(const f32x4*)(wv + 4 * k); t = p + w4 * an; }
#pragma unroll
                    for (int q = 0; q < 4; ++q) { c[4 * k + q] = t[q]; gg[4 * k + q] = g4[q]; } }
                float uo[8];
#pragma unroll
                for (int k = 0; k < 8; ++k) uo[k] = pg8::gelu_tanh(c[k]) * gg[k];
                v4u w; w.x = cvt_pk(uo[0], uo[1]); w.y = cvt_pk(uo[2], uo[3]); w.z = cvt_pk(uo[4], uo[5]); w.w = cvt_pk(uo[6], uo[7]);
                *(v4u*)(U + (size_t)row * DFF + j0) = w;
            }
        }
        GSYNC();
        if (PHMASK & 64) { LOADARGS();
            pg8::Gemm g{U, Wdn_t, MP, DMODEL, DFF}; pg8::StaticOrder S; S.init(MP, DMODEL, G, bx);
            pg8::EpiDown E{a.out + r0 * DMODEL, SS3 + r0 * 32, XN2 + r0 * DMODEL};
            pg8::gemm_phase<pg8::EpiDown, pg8::StaticOrder, PG8_ALIGN, PG8_SP2>(ldsl, g, S, E);
        }
        GSYNC();
    }

    { LOADARGS();
        int tq_ = threadIdx.x; asm volatile("" : "+v"(tq_)); const int ln = tq_ & 63;
        v4u v[4], w[4]; float pp = 0.f, pq = 0.f;
        int m = gw;
        if (m < MTOK) { const v4u* xr = (const v4u*)(XN2 + (size_t)m * DMODEL) + ln; pp = (ln < 32) ? SS3[(size_t)m * 32 + ln] : 0.f;
#pragma unroll
            for (int j = 0; j < 4; ++j) v[j] = xr[64 * j]; }
        for (; m < MTOK; m += NGW) {
            const int nm = m + NGW; const bool more = nm < MTOK;
            if (more) { const v4u* xr = (const v4u*)(XN2 + (size_t)nm * DMODEL) + ln; pq = (ln < 32) ? SS3[(size_t)nm * 32 + ln] : 0.f;
#pragma unroll
                for (int j = 0; j < 4; ++j) w[j] = xr[64 * j]; }
            const float rstd = 1.0f / sqrtf(wave_sum(pp) * (1.0f / DMODEL) + EPS);
            f32x4* xo = (f32x4*)(a.out + (size_t)m * DMODEL) + 2 * ln; const f32x4* gr = (const f32x4*)a.final_g + 2 * ln;
#pragma unroll
            for (int j = 0; j < 4; ++j) { const f32x4 g0 = gr[128 * j], g1 = gr[128 * j + 1];
                const f32x4 x0 = {__uint_as_float(v[j].x << 16), __uint_as_float(v[j].x & 0xffff0000u), __uint_as_float(v[j].y << 16), __uint_as_float(v[j].y & 0xffff0000u)};
                const f32x4 x1 = {__uint_as_float(v[j].z << 16), __uint_as_float(v[j].z & 0xffff0000u), __uint_as_float(v[j].w << 16), __uint_as_float(v[j].w & 0xffff0000u)};
                xo[128 * j] = x0 * rstd * g0; xo[128 * j + 1] = x1 * rstd * g1; }
            if (more) { pp = pq;
#pragma unroll
                for (int j = 0; j < 4; ++j) v[j] = w[j]; }
        }
    }
}

#undef LOADARGS
#undef SS2
#undef SS3
#undef Win_t
#undef Wout_t
#undef Wup_t
#undef Wdn_t
#undef P0
#undef P1
#undef P2
#undef XN1
#undef XN2
#undef U
#undef EP
#undef EA
#undef EG

extern "C" void kernel_launch(void* const* d_in, const int* in_sizes, int n_in, void* d_out, int out_size, void* d_ws, size_t ws_size, hipStream_t stream) {
    static int grid = 0;
    if (grid == 0) {
        if (n_in != 18 || in_sizes[0] != MP * DMODEL || in_sizes[1] != MP * DMODEL || out_size != MTOK * DMODEL || ws_size < WS_END) {
            fprintf(stderr, "kernel_launch: unexpected shapes / workspace (n_in %d, ws %zu, need %zu); nothing launched\n", n_in, ws_size, (size_t)WS_END); grid = -1; return; }
        int dev = 0, cus = 0, per_cu = 0;
        if (hipGetDevice(&dev) != hipSuccess || hipDeviceGetAttribute(&cus, hipDeviceAttributeMultiprocessorCount, dev) != hipSuccess) { grid = -1; return; }
        if (hipFuncSetAttribute((const void*)mk_fwd, hipFuncAttributeMaxDynamicSharedMemorySize, LDS_BYTES) != hipSuccess) { fprintf(stderr, "kernel_launch: hipFuncSetAttribute failed\n"); grid = -1; return; }
        if (hipOccupancyMaxActiveBlocksPerMultiprocessor(&per_cu, (const void*)mk_fwd, NWAVES * 64, LDS_BYTES) != hipSuccess || per_cu < 1) { fprintf(stderr, "kernel_launch: occupancy query says %d\n", per_cu); per_cu = 1; }
        (void)hipGetLastError();
        grid = cus * 1;
    }
    if (grid < 0) return;
    Args a{};
    a.x_prompt = (const float*)d_in[0]; a.x_sample = (const float*)d_in[1]; a.w_in = (const float*)d_in[2]; a.w_out = (const float*)d_in[3];
    a.norm1_g = (const float*)d_in[4]; a.norm2_g = (const float*)d_in[5]; a.final_g = (const float*)d_in[6];
    a.lq1 = (const float*)d_in[7]; a.lk1 = (const float*)d_in[8]; a.lq2 = (const float*)d_in[9]; a.lk2 = (const float*)d_in[10];
    a.subln_g = (const float*)d_in[11]; a.rel_tab = (const float*)d_in[12]; a.na_rpb = (const float*)d_in[13];
    a.w_up = (const float*)d_in[14]; a.conv_w = (const float*)d_in[15]; a.conv_b = (const float*)d_in[16]; a.w_down = (const float*)d_in[17];
    a.out = (float*)d_out; a.ws = (unsigned char*)d_ws;
    void* args[] = {&a};
    const hipError_t le = hipLaunchCooperativeKernel((const void*)mk_fwd, dim3(grid), dim3(NWAVES * 64), args, LDS_BYTES, stream);
    if (le != hipSuccess) fprintf(stderr, "kernel_launch: cooperative launch failed: %s (grid %d)\n", hipGetErrorName(le), grid);
}
```
